# Optimizing an MI355X kernel written in HIP

```python
import jax, jax.numpy as jnp
from jax import lax
import numpy as np

D_MODEL = 1024
BATCH = 2
SEQ = 8192
DEPTH = 2

N_META = 16
BLOCK = 128
N_PAD = BLOCK - N_META
FOX_HEADS = 8
FOX_HEAD_DIM = D_MODEL // 16
FOX_WIDTH = FOX_HEADS * FOX_HEAD_DIM
GLA_HEADS = 4
GLA_WIDTH = D_MODEL // 2
GLA_DV = GLA_WIDTH // GLA_HEADS
GLA_DK = GLA_DV // 2
GLA_KWIDTH = GLA_HEADS * GLA_DK
GLA_GATE_RANK = 16
GLA_GATE_TEMP = 16.0
D_FF = ((8 * D_MODEL // 3 + 127) // 128) * 128
RMS_EPS = 1e-6
SPLIT_SIZES = (FOX_WIDTH, FOX_WIDTH, FOX_WIDTH, FOX_HEADS, GLA_KWIDTH, GLA_KWIDTH, GLA_WIDTH, GLA_GATE_RANK, GLA_WIDTH, D_MODEL, D_MODEL)
N_IN = 3 * FOX_WIDTH + FOX_HEADS + 2 * GLA_KWIDTH + 2 * GLA_WIDTH + GLA_GATE_RANK + 2 * D_MODEL

kernel_name = "hybrid_fox_gla_macaron_meta"


def rmsnorm(x, gain):
    xf = x.astype(jnp.float32)
    y = xf * lax.rsqrt(jnp.mean(xf * xf, axis=-1, keepdims=True) + RMS_EPS)
    return (y * gain.astype(jnp.float32)).astype(x.dtype)


def swiglu(h, w_gu, w_down):
    gate, up = jnp.split(h @ w_gu, 2, axis=-1)
    return (jax.nn.silu(gate) * up) @ w_down


def to_heads(t, n_heads):
    b, l, _ = t.shape
    return t.reshape(b, l, n_heads, -1).transpose(0, 2, 1, 3)


def from_heads(t):
    b, h, l, d = t.shape
    return t.transpose(0, 2, 1, 3).reshape(b, l, h * d)


def fox_attention(q, k, v, log_f, key_valid):
    lp = q.shape[2]
    cum = jnp.cumsum(log_f, axis=-1)
    scale = FOX_HEAD_DIM ** -0.5
    outs = []
    for start in range(0, lp, BLOCK):
        end = start + BLOCK
        s = jnp.einsum('bhqd,bhkd->bhqk', q[:, :, start:end], k[:, :, :end]).astype(jnp.float32) * scale
        s = s + cum[:, :, start:end, None] - cum[:, :, None, :end]
        qpos = jnp.arange(start, end)[:, None]
        kpos = jnp.arange(end)[None, :]
        allowed = (kpos <= qpos) & (key_valid[None, :end] | (kpos == qpos))
        p = jax.nn.softmax(jnp.where(allowed, s, -jnp.inf), axis=-1)
        outs.append(jnp.einsum('bhqk,bhkd->bhqd', p.astype(v.dtype), v[:, :, :end]))
    return jnp.concatenate(outs, axis=2)


def gla_chunked(q, k, v, log_a):
    b, h, lp, dk = q.shape
    dv = v.shape[-1]
    n = lp // BLOCK

    def to_chunks(t):
        return jnp.moveaxis(t.reshape(b, h, n, BLOCK, t.shape[-1]), 2, 0)

    causal = jnp.tril(jnp.ones((BLOCK, BLOCK), dtype=bool))[:, :, None]

    def step(state, inp):
        qi, ki, vi, ai = inp
        cb = jnp.cumsum(ai, axis=2)
        qf, kf, vf = qi.astype(jnp.float32), ki.astype(jnp.float32), vi.astype(jnp.float32)
        inter = jnp.einsum('bhtk,bhkv->bhtv', qf * jnp.exp(cb), state)
        diff = cb[:, :, :, None, :] - cb[:, :, None, :, :]
        decay = jnp.exp(jnp.where(causal, diff, -jnp.inf))
        att = jnp.einsum('bhtk,bhsk,bhtsk->bhts', qf, kf, decay)
        intra = jnp.einsum('bhts,bhsv->bhtv', att, vf)
        last = cb[:, :, -1:, :]
        new_state = jnp.exp(last[:, :, 0, :, None]) * state + jnp.einsum('bhsk,bhsv->bhkv', kf * jnp.exp(last - cb), vf)
        return new_state, (inter + intra).astype(vi.dtype)

    s0 = jnp.zeros((b, h, dk, dv), jnp.float32)
    _, o = lax.scan(step, s0, (to_chunks(q), to_chunks(k), to_chunks(v), to_chunks(log_a)))
    return jnp.moveaxis(o, 0, 2).reshape(b, h, lp, dv)


def token_mixer(h, key_valid, w_in, w_alpha_up, b_alpha, b_f, g_gla_out, w_fox_o, w_gla_o, w_out):
    valid = key_valid.astype(jnp.float32)[None, :, None]
    points = np.cumsum(SPLIT_SIZES)[:-1].tolist()
    fq, fk, fv, ff, gq, gk, gv, ga, gr, g_merge_a, g_merge_b = jnp.split(h @ w_in, points, axis=-1)
    log_f = jax.nn.log_sigmoid(ff.astype(jnp.float32) + b_f.astype(jnp.float32)) * valid
    o_fox = fox_attention(to_heads(fq, FOX_HEADS), to_heads(fk, FOX_HEADS), to_heads(fv, FOX_HEADS),
                          log_f.transpose(0, 2, 1), key_valid)
    log_a = jax.nn.log_sigmoid((ga @ w_alpha_up).astype(jnp.float32) + b_alpha.astype(jnp.float32)) * (valid / GLA_GATE_TEMP)
    gk = gk * valid.astype(gk.dtype)
    o_gla = gla_chunked(to_heads(gq * (GLA_DK ** -0.5), GLA_HEADS), to_heads(gk, GLA_HEADS),
                        to_heads(gv, GLA_HEADS), to_heads(log_a, GLA_HEADS))
    o_gla = rmsnorm(o_gla, g_gla_out.reshape(GLA_HEADS, 1, GLA_DV))
    o_gla = from_heads(o_gla) * jax.nn.silu(gr)
    y = jax.nn.sigmoid(g_merge_a) * (from_heads(o_fox) @ w_fox_o) + jax.nn.sigmoid(g_merge_b) * (o_gla @ w_gla_o)
    return y @ w_out


def setup_inputs(seed: int = 0) -> dict:
    key = jax.random.key(seed)
    ks = jax.random.split(key, 21)

    def nrm(k, shape, scale):
        return jax.random.normal(k, shape, jnp.float32) * scale

    def gain(k):
        return 1.0 + nrm(k, (DEPTH, D_MODEL), 0.02)

    return {
        "x": nrm(ks[0], (BATCH, SEQ, D_MODEL), 1.0),
        "meta_tokens": nrm(ks[1], (N_META, D_MODEL), 1.0),
        "w_in": nrm(ks[2], (DEPTH, D_MODEL, N_IN), D_MODEL ** -0.5),
        "w_alpha_up": nrm(ks[3], (DEPTH, GLA_GATE_RANK, GLA_KWIDTH), GLA_GATE_RANK ** -0.5),
        "b_alpha": nrm(ks[4], (DEPTH, GLA_KWIDTH), 0.1),
        "b_f": 2.0 + nrm(ks[5], (DEPTH, FOX_HEADS), 0.1),
        "g_gla_out": 1.0 + nrm(ks[6], (DEPTH, GLA_WIDTH), 0.02),
        "w_fox_o": nrm(ks[7], (DEPTH, FOX_WIDTH, D_MODEL), FOX_WIDTH ** -0.5),
        "w_gla_o": nrm(ks[8], (DEPTH, GLA_WIDTH, D_MODEL), GLA_WIDTH ** -0.5),
        "w_out": nrm(ks[9], (DEPTH, D_MODEL, D_MODEL), D_MODEL ** -0.5),
        "w_ffn1_gu": nrm(ks[10], (DEPTH, D_MODEL, 2 * D_FF), D_MODEL ** -0.5),
        "w_ffn1_down": nrm(ks[11], (DEPTH, D_FF, D_MODEL), D_FF ** -0.5),
        "w_ffn2_gu": nrm(ks[12], (DEPTH, D_MODEL, 2 * D_FF), D_MODEL ** -0.5),
        "w_ffn2_down": nrm(ks[13], (DEPTH, D_FF, D_MODEL), D_FF ** -0.5),
        "g_pre_ffn1": gain(ks[14]),
        "g_post_ffn1": gain(ks[15]),
        "g_pre_mix": gain(ks[16]),
        "g_post_mix": gain(ks[17]),
        "g_pre_ffn2": gain(ks[18]),
        "g_post_ffn2": gain(ks[19]),
    }


def reference(x, meta_tokens, w_in, w_alpha_up, b_alpha, b_f, g_gla_out, w_fox_o, w_gla_o, w_out,
              w_ffn1_gu, w_ffn1_down, w_ffn2_gu, w_ffn2_down,
              g_pre_ffn1, g_post_ffn1, g_pre_mix, g_post_mix, g_pre_ffn2, g_post_ffn2):
    b = x.shape[0]
    pad = jnp.zeros((b, N_PAD, D_MODEL), x.dtype)
    meta = jnp.broadcast_to(meta_tokens.astype(x.dtype)[None], (b, N_META, D_MODEL))
    h = jnp.concatenate([pad, meta, x], axis=1)
    key_valid = jnp.arange(h.shape[1]) >= N_PAD
    for l in range(DEPTH):
        h = h + 0.5 * rmsnorm(swiglu(rmsnorm(h, g_pre_ffn1[l]), w_ffn1_gu[l], w_ffn1_down[l]), g_post_ffn1[l])
        mix = token_mixer(rmsnorm(h, g_pre_mix[l]), key_valid, w_in[l], w_alpha_up[l], b_alpha[l], b_f[l],
                          g_gla_out[l], w_fox_o[l], w_gla_o[l], w_out[l])
        h = h + rmsnorm(mix, g_post_mix[l])
        h = h + 0.5 * rmsnorm(swiglu(rmsnorm(h, g_pre_ffn2[l]), w_ffn2_gu[l], w_ffn2_down[l]), g_post_ffn2[l])
    return h[:, BLOCK:]
```

```cpp
#include <hip/hip_runtime.h>
#include <hip/hip_cooperative_groups.h>
#include <cstdio>
#include <cstdint>
namespace cg = cooperative_groups;

constexpr int DM = 1024, NB = 2, SEQ = 8192, DEPTH = 2, NMETA = 16, BLK = 128, NPAD = 112;
constexpr int LP = SEQ + BLK;
constexpr int MR = NB * LP;
constexpr int DFF = 2816, NGU = 2 * DFF;
constexpr int NIN = 5144, NINP = 5376;
constexpr int PP = 5120;
constexpr int C_FQ = 0, C_FK = 512, C_FV = 1024, C_GQ = 1536, C_GK = 1792, C_GV = 2048, C_GR = 2560, C_GTA = 3072, C_GTB = 4096, C_YM = 512;
constexpr int NCH = LP / BLK;
constexpr float RMS_EPS = 1e-6f;
constexpr float LOG2E = 1.4426950408889634f;
constexpr float QSCALE = 0.125f * LOG2E;
namespace pg8 {
#define PG8_LAS __attribute__((address_space(3)))
typedef unsigned short bf16_t;
typedef short bf16x8 __attribute__((ext_vector_type(8)));
typedef float f32x4 __attribute__((ext_vector_type(4)));
typedef unsigned u32x4 __attribute__((ext_vector_type(4)));
constexpr int BM = 256, BK = 64, HALF = 128, HTB = HALF * BK * 2  , STAGE_BYTES = 8 * HTB, NXCD = 8, WGM = 8;

__host__ __device__ __forceinline__ int lds_byte(int r, int c) { const int st = (r >> 4) * 2 + (c >> 5), rr = r & 15, cc = c & 31, ob = rr * 64 + cc * 2; return st * 1024 + (ob ^ (((ob >> 9) & 1) << 5)); }
__host__ __device__ __forceinline__ void stage_rc(int b, int& R, int& C) { const int st = b / 1024, sb = b % 1024, swz = sb ^ (((sb >> 9) & 1) << 5); R = (st >> 1) * 16 + swz / 64; C = (st & 1) * 32 + (swz % 64) / 2; }
__host__ __device__ __forceinline__ int perm32(int rho) { const int n = rho >> 4, i = rho & 15; return 8 * (i >> 2) + 4 * n + (i & 3); }

struct Unit { int pm, pn; };
struct Gemm { const bf16_t* A; const bf16_t* Bt; int M, N, K, lda; };

struct StaticOrder {
    int nM, nN, nwg, G, c;
    __host__ __device__ void init(int M, int N, int G_, int c_) { nM = M / BM; nN = N / BM; nwg = nM * nN; G = G_; c = c_; }
    __host__ __device__ bool next(int i, Unit& u) const {
        const long L = (long)i * G + c; if (L >= nwg) return false;
        int wgid = (int)L; { const int q = nwg / NXCD, r = nwg % NXCD, xcd = wgid % NXCD, off = wgid / NXCD; wgid = (xcd < r ? xcd * (q + 1) : r * (q + 1) + (xcd - r) * q) + off; }
        const int nig = WGM * nN, gid = wgid / nig, fm = gid * WGM, gsz = (nM - fm) < WGM ? (nM - fm) : WGM;
        u.pm = fm + ((wgid % nig) % gsz); u.pn = (wgid % nig) / gsz; return true;
    }
    __device__ __forceinline__ void a_ready(const Unit&) const {}
    __device__ __forceinline__ void done(const Unit&) const {}
};

__device__ __forceinline__ unsigned cvt_pk_bf16(float lo, float hi) { unsigned r; asm volatile("v_cvt_pk_bf16_f32 %0, %1, %2" : "=v"(r) : "v"(lo), "v"(hi)); return r; }
typedef float f32x2 __attribute__((ext_vector_type(2)));
__device__ __forceinline__ float bf2f(unsigned short v) { return __uint_as_float(((unsigned)v) << 16); }
__device__ __forceinline__ float fsigmoid(float x) { return __builtin_amdgcn_rcpf(1.0f + __expf(-x)); }
__device__ __forceinline__ float fsilu(float x) { return x * fsigmoid(x); }
__device__ __forceinline__ float logsigmoidf(float x) { return fminf(x, 0.f) - __logf(1.0f + __expf(-fabsf(x))); }
__device__ __forceinline__ u32x4 pack8(const f32x4 v0, const f32x4 v1) { u32x4 w; w.x = cvt_pk_bf16(v0[0], v0[1]); w.y = cvt_pk_bf16(v0[2], v0[3]); w.z = cvt_pk_bf16(v1[0], v1[1]); w.w = cvt_pk_bf16(v1[2], v1[3]); return w; }
__device__ __forceinline__ void unpack8(const u32x4 w, f32x4& v0, f32x4& v1) {
    v0[0] = __uint_as_float(w.x << 16); v0[1] = __uint_as_float(w.x & 0xffff0000u); v0[2] = __uint_as_float(w.y << 16); v0[3] = __uint_as_float(w.y & 0xffff0000u);
    v1[0] = __uint_as_float(w.z << 16); v1[1] = __uint_as_float(w.z & 0xffff0000u); v1[2] = __uint_as_float(w.w << 16); v1[3] = __uint_as_float(w.w & 0xffff0000u); }

struct EpiPlain {
    static constexpr bool PERM = true, AFTER_DRAIN = false;
    bf16_t* O; int ldc;
    __device__ __forceinline__ void operator()(const f32x4 (&acc)[2][2][4][2], const Unit& u, int wr, int wc, int fr, int fq) const {
        const int row0 = u.pm * BM + wr * 64 + fr, col0 = u.pn * BM + wc * 32 + 8 * fq;
#pragma unroll
        for (int ai = 0; ai < 2; ++ai)
#pragma unroll
            for (int m = 0; m < 4; ++m) { bf16_t* rowp = O + (size_t)(row0 + ai * HALF + m * 16) * ldc + col0;
#pragma unroll
                for (int bj = 0; bj < 2; ++bj) *(u32x4*)(rowp + bj * HALF) = pack8(acc[ai][bj][m][0], acc[ai][bj][m][1]); }
    }
};
struct EpiSwiglu {
    static constexpr bool PERM = true, AFTER_DRAIN = false;
    bf16_t* O; int ldc;
    __device__ __forceinline__ void operator()(const f32x4 (&acc)[2][2][4][2], const Unit& u, int wr, int wc, int fr, int fq) const {
        const int row0 = u.pm * BM + wr * 64 + fr, col0 = u.pn * HALF + wc * 32 + 8 * fq;
#pragma unroll
        for (int ai = 0; ai < 2; ++ai)
#pragma unroll
            for (int m = 0; m < 4; ++m) { bf16_t* rowp = O + (size_t)(row0 + ai * HALF + m * 16) * ldc + col0;
                f32x4 o0, o1;
#pragma unroll
                for (int i = 0; i < 4; ++i) { o0[i] = fsilu(acc[ai][0][m][0][i]) * acc[ai][1][m][0][i]; o1[i] = fsilu(acc[ai][0][m][1][i]) * acc[ai][1][m][1][i]; }
                *(u32x4*)rowp = pack8(o0, o1); }
    }
};
struct EpiInProj {
    static constexpr bool PERM = true, AFTER_DRAIN = false;
    bf16_t* P; float* LF; float* GA; const float* b_f;
    __device__ __forceinline__ void operator()(const f32x4 (&acc)[2][2][4][2], const Unit& u, int wr, int wc, int fr, int fq) const {
        const int pn = u.pn; const int row0 = u.pm * BM + wr * 64 + fr;
        if (pn < 20) {
            const int mode = pn < 2 ? 1 : (pn == 6 ? 1 : (pn < 10 ? 0 : (pn < 12 ? 2 : 3)));
            const float sc = pn < 2 ? QSCALE : 0.125f;
            const int col0 = pn * BM + wc * 32 + 8 * fq;
#pragma unroll
            for (int ai = 0; ai < 2; ++ai)
#pragma unroll
                for (int m = 0; m < 4; ++m) { bf16_t* rowp = P + (size_t)(row0 + ai * HALF + m * 16) * PP + col0;
#pragma unroll
                    for (int bj = 0; bj < 2; ++bj) { f32x4 v0 = acc[ai][bj][m][0], v1 = acc[ai][bj][m][1];
                        if (mode == 1) { v0 = v0 * sc; v1 = v1 * sc; }
                        else if (mode == 2) {
#pragma unroll
                            for (int i = 0; i < 4; ++i) { v0[i] = fsilu(v0[i]); v1[i] = fsilu(v1[i]); } }
                        else if (mode == 3) {
#pragma unroll
                            for (int i = 0; i < 4; ++i) { v0[i] = fsigmoid(v0[i]); v1[i] = fsigmoid(v1[i]); } }
                        *(u32x4*)(rowp + bj * HALF) = pack8(v0, v1); } }
        } else if (wc == 0 && fq < 3) {
#pragma unroll
            for (int ai = 0; ai < 2; ++ai)
#pragma unroll
                for (int m = 0; m < 4; ++m) { const int r = row0 + ai * HALF + m * 16; const int p = r >= LP ? r - LP : r;
                    f32x4 v0 = acc[ai][0][m][0], v1 = acc[ai][0][m][1];
                    if (fq == 0) { const float valid = p >= NPAD ? 1.f : 0.f;
#pragma unroll
                        for (int i = 0; i < 4; ++i) { v0[i] = logsigmoidf(v0[i] + b_f[i]) * valid; v1[i] = logsigmoidf(v1[i] + b_f[4 + i]) * valid; }
                        *(f32x4*)(LF + (size_t)r * 8) = v0; *(f32x4*)(LF + (size_t)r * 8 + 4) = v1;
                    } else { float* g = GA + (size_t)r * 16 + 8 * (fq - 1); *(f32x4*)g = v0; *(f32x4*)(g + 4) = v1; } }
        }
    }
};
struct EpiMerge1 {
    static constexpr bool PERM = true, AFTER_DRAIN = false;
    bf16_t* P;
    __device__ __forceinline__ void operator()(const f32x4 (&acc)[2][2][4][2], const Unit& u, int wr, int wc, int fr, int fq) const {
        const int row0 = u.pm * BM + wr * 64 + fr, col0 = u.pn * BM + wc * 32 + 8 * fq;
#pragma unroll
        for (int ai = 0; ai < 2; ++ai)
#pragma unroll
            for (int m = 0; m < 4; ++m) { bf16_t* rowp = P + (size_t)(row0 + ai * HALF + m * 16) * PP + col0;
#pragma unroll
                for (int bj = 0; bj < 2; ++bj) { f32x4 g0, g1; unpack8(*(const u32x4*)(rowp + C_GTA + bj * HALF), g0, g1);
                    *(u32x4*)(rowp + C_YM + bj * HALF) = pack8(acc[ai][bj][m][0] * g0, acc[ai][bj][m][1] * g1); } }
    }
};
struct EpiMerge2 {
    static constexpr bool PERM = true, AFTER_DRAIN = false;
    bf16_t* P;
    __device__ __forceinline__ void operator()(const f32x4 (&acc)[2][2][4][2], const Unit& u, int wr, int wc, int fr, int fq) const {
        const int row0 = u.pm * BM + wr * 64 + fr, col0 = u.pn * BM + wc * 32 + 8 * fq;
#pragma unroll
        for (int ai = 0; ai < 2; ++ai)
#pragma unroll
            for (int m = 0; m < 4; ++m) { bf16_t* rowp = P + (size_t)(row0 + ai * HALF + m * 16) * PP + col0;
#pragma unroll
                for (int bj = 0; bj < 2; ++bj) { f32x4 g0, g1, t0, t1; unpack8(*(const u32x4*)(rowp + C_GTB + bj * HALF), g0, g1); unpack8(*(const u32x4*)(rowp + C_YM + bj * HALF), t0, t1);
                    *(u32x4*)(rowp + C_YM + bj * HALF) = pack8(t0 + acc[ai][bj][m][0] * g0, t1 + acc[ai][bj][m][1] * g1); } }
    }
};

template <class Epi, class Sched, bool ALIGN_EPI = false, bool SP2 = false>
__device__ __forceinline__ void gemm_phase(PG8_LAS unsigned char* lds, const Gemm g, const Sched& S, const Epi& E) {
    int tid_ = threadIdx.x; asm volatile("" : "+v"(tid_)); const int tid = tid_, wid = __builtin_amdgcn_readfirstlane(tid >> 6), lane = tid & 63, wr = wid >> 2, wc = wid & 3, fr = lane & 15, fq = lane >> 4;
    const int K = g.K, nt = K / BK;
    unsigned voffA[2], voffB[2];
#pragma unroll
    for (int i = 0; i < 2; ++i) { int R, C; stage_rc(tid * 16 + i * 8192, R, C); const int Rb = Epi::PERM ? ((R & ~31) + perm32(R & 31)) : R;
        voffA[i] = (unsigned)(R * g.lda + C) * 2u; voffB[i] = (unsigned)(Rb * K + C) * 2u; }
    const size_t kstep = (size_t)(BK * 2);
    const size_t hstep = (size_t)HALF * K * 2;
    const size_t tstep = 2 * hstep; const size_t hstepA = (size_t)HALF * g.lda * 2, tstepA = 2 * hstepA;
    const unsigned ldsw = (unsigned)wid * 1024u;
    const int aoff = lds_byte(wr * 64 + fr, fq * 8), boff = lds_byte(wc * 32 + fr, fq * 8);
#define PG8_SA(b, h) (((b) * 2 + (h)) * HTB)
#define PG8_SB(b, h) ((4 + (b) * 2 + (h)) * HTB)
#define PG8_STAGE(bufoff, gbase, voff) do { _Pragma("unroll") for (int _i = 0; _i < 2; ++_i) \
        __builtin_amdgcn_global_load_lds((const unsigned*)((const char*)(gbase) + (voff)[_i]), (PG8_LAS unsigned*)(lds + (bufoff) + ldsw + _i * 8192), 16, 0, 0); } while (0)
#define PG8_LDA(dst, b, h) do { _Pragma("unroll") for (int m = 0; m < 4; ++m) _Pragma("unroll") for (int k = 0; k < 2; ++k) dst[m][k] = *(const PG8_LAS bf16x8*)(lds + PG8_SA(b, h) + aoff + m * 2048 + k * 1024); } while (0)
#define PG8_LDB(dst, b, h) do { _Pragma("unroll") for (int n = 0; n < 2; ++n) _Pragma("unroll") for (int k = 0; k < 2; ++k) dst[n][k] = *(const PG8_LAS bf16x8*)(lds + PG8_SB(b, h) + boff + n * 2048 + k * 1024); } while (0)
#define PG8_MMA(ai, bj, At, Bt) do { __builtin_amdgcn_s_setprio(1); _Pragma("unroll") for (int m = 0; m < 4; ++m) _Pragma("unroll") for (int n = 0; n < 2; ++n) _Pragma("unroll") for (int k = 0; k < 2; ++k) \
        acc[ai][bj][m][n] = __builtin_amdgcn_mfma_f32_16x16x32_bf16(Bt[n][k], At[m][k], acc[ai][bj][m][n], 0, 0, 0); __builtin_amdgcn_s_setprio(0); } while (0)
#define PG8_WAIT_V(n) asm volatile("s_waitcnt vmcnt(" #n ")" ::: "memory")
#define PG8_WAIT_L(n) asm volatile("s_waitcnt lgkmcnt(" #n ")" ::: "memory")
#define PG8_BAR __builtin_amdgcn_s_barrier()
#define PG8_SCHED __builtin_amdgcn_sched_barrier(0)
    Unit cur, nxt; int ui = 0;
    if (!S.next(0, cur)) return;
    f32x4 acc[2][2][4][2];
#pragma unroll
    for (int a = 0; a < 2; ++a)
#pragma unroll
        for (int b = 0; b < 2; ++b)
#pragma unroll
            for (int m = 0; m < 4; ++m)
#pragma unroll
                for (int n = 0; n < 2; ++n) acc[a][b][m][n] = (f32x4){0.f, 0.f, 0.f, 0.f};
    bf16x8 At[4][2], B0[2][2], B1[2][2];
    const char* cA = (const char*)g.A + (size_t)cur.pm * tstepA; const char* cB = (const char*)g.Bt + (size_t)cur.pn * tstep;
    S.a_ready(cur);
    if constexpr (SP2) {
        PG8_STAGE(PG8_SB(0, 0), cB, voffB); PG8_STAGE(PG8_SB(0, 1), cB + hstep, voffB); PG8_STAGE(PG8_SA(0, 0), cA, voffA); PG8_STAGE(PG8_SA(0, 1), cA + hstepA, voffA);
        if (wr == 1) PG8_BAR;
        PG8_WAIT_V(2); PG8_BAR;
        PG8_STAGE(PG8_SB(1, 0), cB + kstep, voffB); PG8_STAGE(PG8_SA(1, 0), cA + kstep, voffA); PG8_STAGE(PG8_SB(1, 1), cB + hstep + kstep, voffB);
        PG8_WAIT_V(6); PG8_BAR;
    } else {
        PG8_STAGE(PG8_SB(0, 0), cB, voffB); PG8_STAGE(PG8_SA(0, 0), cA, voffA); PG8_STAGE(PG8_SB(0, 1), cB + hstep, voffB); PG8_STAGE(PG8_SA(0, 1), cA + hstepA, voffA);
        if (wr == 1) PG8_BAR;
        PG8_WAIT_V(4); PG8_BAR;
        PG8_STAGE(PG8_SB(1, 0), cB + kstep, voffB); PG8_STAGE(PG8_SA(1, 0), cA + kstep, voffA); PG8_STAGE(PG8_SB(1, 1), cB + hstep + kstep, voffB);
        PG8_WAIT_V(6); PG8_BAR;
    }
    for (;;) {
        const bool has_next = S.next(ui + 1, nxt);
        const char* nA = has_next ? (const char*)g.A + (size_t)nxt.pm * tstepA : cA; const char* nB = has_next ? (const char*)g.Bt + (size_t)nxt.pn * tstep : cB;
        for (int t = 0; t < nt; t += 2) {
            const bool last = (t == nt - 2);
            const char* a1 = cA + (size_t)(t + 1) * kstep;
            const char* a2 = last ? nA : cA + (size_t)(t + 2) * kstep; const char* b2 = last ? nB : cB + (size_t)(t + 2) * kstep;
            const char* a3 = a2 + kstep; const char* b3 = b2 + kstep;
            if (last && has_next) S.a_ready(nxt);
            if constexpr (SP2) {
            PG8_LDB(B0, 0, 0); PG8_LDB(B1, 0, 1); PG8_SCHED; PG8_LDA(At, 0, 0); PG8_STAGE(PG8_SA(1, 1), a1 + hstepA, voffA);
            PG8_WAIT_V(8); PG8_WAIT_L(0); PG8_BAR; PG8_MMA(0, 0, At, B0); PG8_MMA(0, 1, At, B1); PG8_BAR; PG8_SCHED;
            PG8_LDA(At, 0, 1); PG8_STAGE(PG8_SB(0, 0), b2, voffB); PG8_STAGE(PG8_SB(0, 1), b2 + hstep, voffB); PG8_STAGE(PG8_SA(0, 0), a2, voffA);
            PG8_WAIT_V(8); PG8_WAIT_L(0); PG8_BAR; PG8_MMA(1, 0, At, B0); PG8_MMA(1, 1, At, B1); PG8_BAR; PG8_SCHED;
            PG8_LDB(B0, 1, 0); PG8_LDB(B1, 1, 1); PG8_SCHED; PG8_LDA(At, 1, 0); PG8_STAGE(PG8_SA(0, 1), a2 + hstepA, voffA);
            PG8_WAIT_V(8); PG8_WAIT_L(0); PG8_BAR; PG8_MMA(0, 0, At, B0); PG8_MMA(0, 1, At, B1); PG8_BAR; PG8_SCHED;
            PG8_LDA(At, 1, 1); PG8_STAGE(PG8_SB(1, 0), b3, voffB); PG8_STAGE(PG8_SB(1, 1), b3 + hstep, voffB); PG8_STAGE(PG8_SA(1, 0), a3, voffA);
            PG8_WAIT_V(8); PG8_WAIT_L(0); PG8_BAR; PG8_MMA(1, 0, At, B0); PG8_MMA(1, 1, At, B1); PG8_BAR; PG8_SCHED;
            } else {
            PG8_LDB(B0, 0, 0); PG8_SCHED; PG8_LDA(At, 0, 0); PG8_STAGE(PG8_SA(1, 1), a1 + hstepA, voffA);
            PG8_WAIT_L(8); PG8_BAR; PG8_WAIT_L(0); PG8_MMA(0, 0, At, B0); PG8_BAR; PG8_SCHED;
            PG8_LDB(B1, 0, 1); PG8_STAGE(PG8_SB(0, 0), b2, voffB);
            PG8_BAR; PG8_WAIT_L(0); PG8_MMA(0, 1, At, B1); PG8_BAR;
            PG8_LDA(At, 0, 1); PG8_STAGE(PG8_SA(0, 0), a2, voffA);
            PG8_BAR; PG8_WAIT_L(0); PG8_MMA(1, 0, At, B0); PG8_BAR; PG8_SCHED;
            PG8_STAGE(PG8_SB(0, 1), b2 + hstep, voffB);
            PG8_WAIT_V(6); PG8_BAR; PG8_MMA(1, 1, At, B1); PG8_BAR;
            PG8_LDB(B0, 1, 0); PG8_SCHED; PG8_LDA(At, 1, 0); PG8_STAGE(PG8_SA(0, 1), a2 + hstepA, voffA);
            PG8_WAIT_L(8); PG8_BAR; PG8_WAIT_L(0); PG8_MMA(0, 0, At, B0); PG8_BAR; PG8_SCHED;
            PG8_LDB(B1, 1, 1); PG8_STAGE(PG8_SB(1, 0), b3, voffB);
            PG8_BAR; PG8_WAIT_L(0); PG8_MMA(0, 1, At, B1); PG8_BAR;
            PG8_LDA(At, 1, 1); PG8_STAGE(PG8_SA(1, 0), a3, voffA);
            PG8_BAR; PG8_WAIT_L(0); PG8_MMA(1, 0, At, B0); PG8_BAR; PG8_SCHED;
            PG8_STAGE(PG8_SB(1, 1), b3 + hstep, voffB);
            PG8_WAIT_V(6); PG8_BAR; PG8_MMA(1, 1, At, B1); PG8_BAR;
            }
        }
        if constexpr (ALIGN_EPI) { if (wr == 0) PG8_BAR; }
        if constexpr (!Epi::AFTER_DRAIN) { E(acc, cur, wr, wc, fr, fq); S.done(cur); }
        if (!has_next) break;
#pragma unroll
        for (int a = 0; a < 2; ++a)
#pragma unroll
            for (int b = 0; b < 2; ++b)
#pragma unroll
                for (int m = 0; m < 4; ++m)
#pragma unroll
                    for (int n = 0; n < 2; ++n) acc[a][b][m][n] = (f32x4){0.f, 0.f, 0.f, 0.f};
        cur = nxt; cA = nA; cB = nB; ++ui;
        if constexpr (ALIGN_EPI) { if (wr == 1) PG8_BAR; }
    }
    PG8_WAIT_V(0);
    if constexpr (!ALIGN_EPI) { if (wr == 0) PG8_BAR; }
    PG8_BAR;
    if constexpr (Epi::AFTER_DRAIN) { E.fused(acc, cur, wr, wc, fr, fq, lds, wid, lane); S.done(cur); }
#undef PG8_SA
#undef PG8_SB
#undef PG8_STAGE
#undef PG8_LDA
#undef PG8_LDB
#undef PG8_MMA
#undef PG8_WAIT_V
#undef PG8_WAIT_L
#undef PG8_BAR
#undef PG8_SCHED
}
}

typedef unsigned short bf16_t;
typedef short bf16x8 __attribute__((ext_vector_type(8)));
typedef short s16x4 __attribute__((ext_vector_type(4)));
typedef float f32x4 __attribute__((ext_vector_type(4)));
typedef float f32x16 __attribute__((ext_vector_type(16)));
typedef unsigned u32x4 __attribute__((ext_vector_type(4)));
typedef unsigned u32x2 __attribute__((ext_vector_type(2)));
using pg8::bf2f; using pg8::cvt_pk_bf16; using pg8::fsigmoid; using pg8::logsigmoidf;

constexpr int NTHREADS = 512, NWAVES = 8;
constexpr int LDS_MAIN = 131072;
constexpr int LDS_BYTES = LDS_MAIN + 256;

constexpr size_t SZ_WGU = (size_t)NGU * DM * 2, SZ_WD = (size_t)DM * DFF * 2, SZ_WIN = (size_t)NINP * DM * 2, SZ_WO5 = (size_t)DM * 512 * 2, SZ_WOUT = (size_t)DM * DM * 2;
constexpr size_t WS_WGU1 = 0, WS_WD1 = WS_WGU1 + SZ_WGU, WS_WIN = WS_WD1 + SZ_WD, WS_WFO = WS_WIN + SZ_WIN, WS_WGO = WS_WFO + SZ_WO5, WS_WOUT = WS_WGO + SZ_WO5,
                 WS_WGU2 = WS_WOUT + SZ_WOUT, WS_WD2 = WS_WGU2 + SZ_WGU, WS_HM = WS_WD2 + SZ_WD;
constexpr size_t WS_LF = WS_HM + (size_t)NB * BLK * DM * 4;
constexpr size_t WS_GA = WS_LF + (size_t)MR * 8 * 4;
constexpr size_t WS_CUM = WS_GA + (size_t)MR * 16 * 4;
constexpr size_t WS_DEC = WS_CUM + (size_t)16 * LP * 4;
constexpr size_t WS_KMAX = WS_DEC + (size_t)8 * NCH * 64 * 4;
constexpr size_t WS_BAR = WS_KMAX + 256;
constexpr size_t WS_R1 = WS_BAR + 16384;
constexpr size_t WS_R2 = WS_R1 + (size_t)MR * DM * 2;
constexpr size_t WS_END = WS_R2 + (size_t)MR * PP * 2;
static_assert(WS_END <= (size_t)256 * 1024 * 1024, "workspace map exceeds 256 MiB");
static_assert((size_t)8 * NCH * 128 * 64 * 4 <= (size_t)MR * DM * 2, "GLA states must fit region R1");

struct Args {
    const float* x; const float* meta; const float* w_in; const float* w_alpha_up; const float* b_alpha; const float* b_f; const float* g_gla_out;
    const float* w_fox_o; const float* w_gla_o; const float* w_out; const float* w_gu1; const float* w_d1; const float* w_gu2; const float* w_d2;
    const float* g_pre1; const float* g_post1; const float* g_prem; const float* g_postm; const float* g_pre2; const float* g_post2;
    float* out; unsigned char* ws;
};

__device__ __forceinline__ float* hrow(float* out, float* hm, int r) {
    const int b = r >= LP ? 1 : 0, p = r - b * LP;
    return p < BLK ? hm + (size_t)(b * BLK + p) * DM : out + ((size_t)b * SEQ + (p - BLK)) * DM;
}
__device__ __forceinline__ int otid() { int t = threadIdx.x; asm volatile("" : "+v"(t)); return t; }
__device__ __forceinline__ float wave_sum(float v) {
#pragma unroll
    for (int o = 32; o > 0; o >>= 1) v += __shfl_xor(v, o);
    return v;
}

__device__ __forceinline__ int src_col(int kind, int n) {
    if (kind == 0) return n;
    if (kind == 1) { const int t = n >> 8, w = n & 255; return (w >> 7) * DFF + 128 * t + (w & 127); }
    if (n < 1536) return n;
    if (n < 2560) return n + 8;
    if (n < 5120) return n + 24;
    if (n < 5128) return n - 5120 + 1536;
    if (n < 5144) return n - 5128 + 2568;
    return -1;
}
constexpr int CT0 = 1408, CT1 = CT0 + 704, CT2 = CT1 + 1344, CT3 = CT2 + 128, CT4 = CT3 + 128, CT5 = CT4 + 256, CT6 = CT5 + 1408, CT7 = CT6 + 704;
__device__ __forceinline__ void conv_setup(const Args& ar, int layer, int t, int tid, const float*& lp, bool& ok, bf16_t*& sp) {
    unsigned char* ws = ar.ws;
    const float* src; bf16_t* dst; int K, ldsrc, kind, tt;
    if (t < CT0)      { src = ar.w_gu1 + (size_t)layer * DM * NGU;   dst = (bf16_t*)(ws + WS_WGU1); K = DM;  ldsrc = NGU; kind = 1; tt = t; }
    else if (t < CT1) { src = ar.w_d1 + (size_t)layer * DFF * DM;    dst = (bf16_t*)(ws + WS_WD1);  K = DFF; ldsrc = DM;  kind = 0; tt = t - CT0; }
    else if (t < CT2) { src = ar.w_in + (size_t)layer * DM * NIN;    dst = (bf16_t*)(ws + WS_WIN);  K = DM;  ldsrc = NIN; kind = 2; tt = t - CT1; }
    else if (t < CT3) { src = ar.w_fox_o + (size_t)layer * 512 * DM; dst = (bf16_t*)(ws + WS_WFO);  K = 512; ldsrc = DM;  kind = 0; tt = t - CT2; }
    else if (t < CT4) { src = ar.w_gla_o + (size_t)layer * 512 * DM; dst = (bf16_t*)(ws + WS_WGO);  K = 512; ldsrc = DM;  kind = 0; tt = t - CT3; }
    else if (t < CT5) { src = ar.w_out + (size_t)layer * DM * DM;    dst = (bf16_t*)(ws + WS_WOUT); K = DM;  ldsrc = DM;  kind = 0; tt = t - CT4; }
    else if (t < CT6) { src = ar.w_gu2 + (size_t)layer * DM * NGU;   dst = (bf16_t*)(ws + WS_WGU2); K = DM;  ldsrc = NGU; kind = 1; tt = t - CT5; }
    else              { src = ar.w_d2 + (size_t)layer * DFF * DM;    dst = (bf16_t*)(ws + WS_WD2);  K = DFF; ldsrc = DM;  kind = 0; tt = t - CT6; }
    const int nk = K >> 6, n0 = (tt / nk) << 6, k0 = (tt % nk) << 6;
    const int sc = src_col(kind, n0 + 8 * (tid & 7));
    ok = sc >= 0; lp = src + (size_t)(k0 + (tid >> 3)) * ldsrc + (ok ? sc : 0);
    sp = dst + (size_t)(n0 + (tid >> 3)) * K + k0 + 8 * (tid & 7);
}
__device__ __forceinline__ void convert_phase(const Args& ar, int layer, unsigned char* lds) {
    const int tid = otid(); const int kl = tid >> 3, c8 = tid & 7;
    const float* lp; bool ok; bf16_t* sp; f32x4 v0 = {0.f, 0.f, 0.f, 0.f}, v1 = v0;
    int t = blockIdx.x, buf = 0;
    if (t < CT7) { conv_setup(ar, layer, t, tid, lp, ok, sp); if (ok) { v0 = *(const f32x4*)lp; v1 = *(const f32x4*)(lp + 4); } else { v0 = (f32x4){0.f, 0.f, 0.f, 0.f}; v1 = v0; } }
#pragma unroll 1
    for (; t < CT7; t += gridDim.x) {
        bf16_t* T = (bf16_t*)(lds + buf * 9216);
        { const unsigned a = cvt_pk_bf16(v0[0], v0[1]), b = cvt_pk_bf16(v0[2], v0[3]), cc = cvt_pk_bf16(v1[0], v1[1]), d = cvt_pk_bf16(v1[2], v1[3]);
          bf16_t* q = T + (8 * c8) * 72 + (kl ^ (8 * c8));
          q[0] = (bf16_t)a; q[72] = (bf16_t)(a >> 16); q[144] = (bf16_t)b; q[216] = (bf16_t)(b >> 16); q[288] = (bf16_t)cc; q[360] = (bf16_t)(cc >> 16); q[432] = (bf16_t)d; q[504] = (bf16_t)(d >> 16); }
        __syncthreads();
        bf16_t* spc = sp;
        const int tn = t + gridDim.x;
        if (tn < CT7) { conv_setup(ar, layer, tn, tid, lp, ok, sp); if (ok) { v0 = *(const f32x4*)lp; v1 = *(const f32x4*)(lp + 4); } else { v0 = (f32x4){0.f, 0.f, 0.f, 0.f}; v1 = v0; } }
        *(u32x4*)spc = *(const u32x4*)(T + kl * 72 + ((8 * c8) ^ (8 * ((kl >> 3) & 7))));
        buf ^= 1;
    }
    __syncthreads();
}

template <int MODE>
__device__ __forceinline__ void norm_phase(const Args& ar, const bf16_t* y, bf16_t* a, float coef, const float* gpost, const float* gpre, const bool dry = false) {
    float* hm = (float*)(ar.ws + WS_HM);
    const int tid = otid(); const int lane = tid & 63, wv = tid >> 6;
    const int stride = gridDim.x * NWAVES;
    for (int r0 = blockIdx.x * NWAVES + wv; r0 < MR; r0 += 2 * stride) {
        const bool has1 = r0 + stride < MR; const int rr[2] = {r0, has1 ? r0 + stride : r0};
        f32x4 h[2][4], v[2][4]; float* hp[2];
#pragma unroll
        for (int q = 0; q < 2; ++q) { const int r = rr[q]; hp[q] = hrow(ar.out, hm, r); const int b = r >= LP ? 1 : 0, p = r - b * LP;
            if (MODE == 0) {
#pragma unroll
                for (int i = 0; i < 4; ++i) { const int c = 256 * i + 4 * lane;
                    if (p < NPAD) h[q][i] = (f32x4){0.f, 0.f, 0.f, 0.f};
                    else if (p < BLK) h[q][i] = *(const f32x4*)(ar.meta + (size_t)(p - NPAD) * DM + c);
                    else h[q][i] = *(const f32x4*)(ar.x + ((size_t)b * SEQ + (p - BLK)) * DM + c); }
            } else {
#pragma unroll
                for (int i = 0; i < 4; ++i) { const int c = 256 * i + 4 * lane; const u32x2 w = __builtin_nontemporal_load((const u32x2*)(y + (size_t)r * DM + c));
                    v[q][i][0] = __uint_as_float(w.x << 16); v[q][i][1] = __uint_as_float(w.x & 0xffff0000u); v[q][i][2] = __uint_as_float(w.y << 16); v[q][i][3] = __uint_as_float(w.y & 0xffff0000u);
                    h[q][i] = __builtin_nontemporal_load((const f32x4*)(hp[q] + c)); }
            } }
#pragma unroll
        for (int q = 0; q < 2; ++q) { if (q == 1 && !has1) break; const int r = rr[q];
            if (MODE == 1) { float ss = 0.f;
#pragma unroll
                for (int i = 0; i < 4; ++i) ss += v[q][i][0] * v[q][i][0] + v[q][i][1] * v[q][i][1] + v[q][i][2] * v[q][i][2] + v[q][i][3] * v[q][i][3];
                ss = wave_sum(ss); const float rs = coef * rsqrtf(ss * (1.0f / DM) + RMS_EPS);
#pragma unroll
                for (int i = 0; i < 4; ++i) { const int c = 256 * i + 4 * lane; const f32x4 g = *(const f32x4*)(gpost + c); h[q][i] = h[q][i] + v[q][i] * g * rs; } }
#pragma unroll
            for (int i = 0; i < 4; ++i) if (!dry) __builtin_nontemporal_store(h[q][i], (f32x4*)(hp[q] + 256 * i + 4 * lane));
            if (gpre) { float ss = 0.f;
#pragma unroll
                for (int i = 0; i < 4; ++i) ss += h[q][i][0] * h[q][i][0] + h[q][i][1] * h[q][i][1] + h[q][i][2] * h[q][i][2] + h[q][i][3] * h[q][i][3];
                ss = wave_sum(ss); const float rs = rsqrtf(ss * (1.0f / DM) + RMS_EPS);
#pragma unroll
                for (int i = 0; i < 4; ++i) { const int c = 256 * i + 4 * lane; const f32x4 g = *(const f32x4*)(gpre + c); const f32x4 o = h[q][i] * g * rs;
                    u32x2 w; w.x = cvt_pk_bf16(o[0], o[1]); w.y = cvt_pk_bf16(o[2], o[3]); if (!dry) *(u32x2*)(a + (size_t)r * DM + c) = w; } }
        }
    }
}

__device__ __forceinline__ void cumsum_phase(const float* LF, float* CUM, unsigned char* lds) {
    if (blockIdx.x >= 16) return;
    const int tid = otid(), lane = tid & 63, wv = tid >> 6, seq = blockIdx.x, b = seq >> 3, hh = seq & 7, p0 = 17 * tid;
    float* wt = (float*)lds;
    float v[17]; float s = 0.f;
#pragma unroll
    for (int i = 0; i < 17; ++i) { const int p = p0 + i; const float x = p < LP ? LF[(size_t)(b * LP + p) * 8 + hh] : 0.f; s += x; v[i] = s; }
    float sc = s;
#pragma unroll
    for (int o = 1; o < 64; o <<= 1) { const float t = __shfl_up(sc, o); if (lane >= o) sc += t; }
    if (lane == 63) wt[wv] = sc;
    __syncthreads();
    float off = sc - s;
#pragma unroll
    for (int w2 = 0; w2 < 8; ++w2) off += (w2 < wv) ? wt[w2] : 0.f;
#pragma unroll
    for (int i = 0; i < 17; ++i) { const int p = p0 + i; if (p < LP) CUM[(size_t)seq * LP + p] = v[i] + off; }
    __syncthreads();
}

constexpr float PRUNE_T = 40.0f;
__device__ __forceinline__ void kmax_phase(const bf16_t* P, unsigned* KMAX, unsigned char* lds) {
    const int tid = otid(), lane = tid & 63, wv = tid >> 6; float mx0 = 0.f, mx1 = 0.f;
    const int stride = gridDim.x * NWAVES;
    for (int rb = blockIdx.x * NWAVES + wv; rb < MR; rb += 9 * stride) {
        u32x4 kv9[9];
#pragma unroll
        for (int q = 0; q < 9; ++q) { const int r = rb + q * stride; kv9[q] = r < MR ? *(const u32x4*)(P + (size_t)r * PP + C_FK + 8 * lane) : (u32x4){0u, 0u, 0u, 0u}; }
#pragma unroll
        for (int q = 0; q < 9; ++q) { const int r = rb + q * stride; const u32x4 kv = kv9[q];
            const float a0 = __uint_as_float(kv.x << 16), a1 = __uint_as_float(kv.x & 0xffff0000u), a2 = __uint_as_float(kv.y << 16), a3 = __uint_as_float(kv.y & 0xffff0000u),
                        a4 = __uint_as_float(kv.z << 16), a5 = __uint_as_float(kv.z & 0xffff0000u), a6 = __uint_as_float(kv.w << 16), a7 = __uint_as_float(kv.w & 0xffff0000u);
            float ss = a0 * a0 + a1 * a1 + a2 * a2 + a3 * a3 + a4 * a4 + a5 * a5 + a6 * a6 + a7 * a7;
            ss += __shfl_xor(ss, 1); ss += __shfl_xor(ss, 2); ss += __shfl_xor(ss, 4);
            if (r >= LP) mx1 = fmaxf(mx1, ss); else mx0 = fmaxf(mx0, ss); }
    }
    float* red = (float*)lds;
    if ((lane & 7) == 0) { red[(lane >> 3) * 8 + wv] = mx0; red[64 + (lane >> 3) * 8 + wv] = mx1; }
    __syncthreads();
    if (tid < 16) { float m = 0.f;
#pragma unroll
        for (int i = 0; i < 8; ++i) m = fmaxf(m, red[tid * 8 + i]);
        atomicMax(KMAX + tid, __float_as_uint(m)); }
    __syncthreads();
}
__device__ __forceinline__ void attn_unit(int b, int hh, int qb, bf16_t* P, const float* CUM, const unsigned* KMAX, unsigned char* lds, const bool dry) {
    const int tid = otid(), lane = tid & 63, w = tid >> 6, g = w >> 2, wq = w & 3, l31 = lane & 31, hi = lane >> 5, gt = tid & 255;
    const size_t rowbase = (size_t)b * LP;
    const int qp = BLK * qb + 32 * wq + l31;
    const float* cum = CUM + (size_t)(b * 8 + hh) * LP;
    unsigned char* gl = lds + g * 40960;
    float* comb = (float*)(lds + 81920);
    float* misc = (float*)(lds + 116736);
    const bool active = (BLK * qb + 32 * wq + 31) >= NPAD;
    bf16x8 qf[4];
    { const bf16_t* qptr = P + (rowbase + qp) * PP + C_FQ + 64 * hh + 8 * hi;
#pragma unroll
      for (int s = 0; s < 4; ++s) qf[s] = *(const bf16x8*)(qptr + 16 * s); }
    const float ct = cum[qp] * LOG2E;
    const int jhi = 4 * qb + 3;
    const int srow = gt >> 3, sc8 = gt & 7;
    u32x4 kreg[2], vreg[2]; float csreg[2];
    const int vrow = gt & 31, vc8 = gt >> 5;
#define ATT_LOAD2(jj) do { _Pragma("unroll") for (int s2 = 0; s2 < 2; ++s2) { const int j_ = max((jj) - s2, 0); \
        const bf16_t* kp = P + (rowbase + 32 * j_ + srow) * PP + 64 * hh + 8 * sc8; kreg[s2] = *(const u32x4*)(kp + C_FK); vreg[s2] = *(const u32x4*)(P + (rowbase + 32 * j_ + vrow) * PP + C_FV + 64 * hh + 8 * vc8); \
        csreg[s2] = cum[32 * j_ + (gt & 31)]; } } while (0)
    ATT_LOAD2(jhi - 2 * g);
    const unsigned kmax_bits = KMAX[b * 8 + hh];
    const int jcand = 3 + tid; const float cum_blk = cum[BLK * qb], cum_cand = jcand < 4 * qb ? cum[32 * jcand + 31] : 0.f;
    { float qn = 0.f;
#pragma unroll
      for (int s = 0; s < 4; ++s)
#pragma unroll
          for (int j = 0; j < 8; ++j) { const float v = bf2f((unsigned short)qf[s][j]); qn += v * v; }
      qn += __shfl_xor(qn, 32);
#pragma unroll
      for (int o = 16; o > 0; o >>= 1) qn = fmaxf(qn, __shfl_xor(qn, o));
      if (lane == 0) misc[w] = qn;
      if (tid == 0) ((int*)misc)[8] = 3; }
    __syncthreads();
    { float qn = misc[0];
#pragma unroll
      for (int i = 1; i < 8; ++i) qn = fmaxf(qn, misc[i]);
      const float kmax = sqrtf(__uint_as_float(kmax_bits));
      const float thr = -(2.02f * sqrtf(qn) * kmax + PRUNE_T) * (1.0f / LOG2E);
      if (jcand < 4 * qb) { if (cum_blk - cum_cand < thr) atomicMax((int*)misc + 8, jcand + 1); } }
    __syncthreads();
    const int jlo = ((const int*)misc)[8];
    const int nchunk = (jhi - jlo + 2) >> 1, niter = (nchunk + 1) >> 1;
    float m = -INFINITY, lsum = 0.f; f32x16 o0, o1;
#pragma unroll
    for (int r = 0; r < 16; ++r) { o0[r] = 0.f; o1[r] = 0.f; }
#define ATT_STORE2(jj, bufsel) do { _Pragma("unroll") for (int s2 = 0; s2 < 2; ++s2) { const int j_ = (jj) - s2; if (j_ >= jlo) { unsigned char* bb = gl + (bufsel) * 20480 + s2 * 10240; bf16_t* Kl_ = (bf16_t*)bb; bf16_t* vt = (bf16_t*)(bb + 4608) + (8 * vc8) * 40 + vrow; \
        *(u32x4*)(Kl_ + srow * 72 + 8 * sc8) = kreg[s2]; \
        vt[0] = (bf16_t)vreg[s2].x; vt[40] = (bf16_t)(vreg[s2].x >> 16); vt[80] = (bf16_t)vreg[s2].y; vt[120] = (bf16_t)(vreg[s2].y >> 16); \
        vt[160] = (bf16_t)vreg[s2].z; vt[200] = (bf16_t)(vreg[s2].z >> 16); vt[240] = (bf16_t)vreg[s2].w; vt[280] = (bf16_t)(vreg[s2].w >> 16); \
        if (gt < 32) ((float*)(bb + 9728))[gt] = (32 * j_ + gt >= NPAD) ? csreg[s2] * LOG2E : INFINITY; } } } while (0)
    ATT_STORE2(jhi - 2 * g, 0); ATT_LOAD2(jhi - 2 * g - 4);
    __syncthreads();
    for (int it = 0; it < niter; ++it) {
        const int ja = jhi - 2 * g - 4 * it;
        ATT_STORE2(ja - 4, (it + 1) & 1);
        ATT_LOAD2(ja - 8);
#pragma unroll
        for (int s2 = 0; s2 < 2; ++s2) { const int j = ja - s2;
        if (j >= jlo && active && j <= 4 * qb + wq) {
            const unsigned char* bb = gl + (it & 1) * 20480 + s2 * 10240; const bf16_t* Kl = (const bf16_t*)bb; const bf16_t* Vt = (const bf16_t*)(bb + 4608); const float* csl = (const float*)(bb + 9728);
            f32x16 sacc;
#pragma unroll
            for (int g4 = 0; g4 < 4; ++g4) { const f32x4 c4 = *(const f32x4*)(csl + 8 * g4 + 4 * hi);
#pragma unroll
                for (int i = 0; i < 4; ++i) sacc[4 * g4 + i] = ct - c4[i]; }
#pragma unroll
            for (int s = 0; s < 4; ++s) { const bf16x8 kf = *(const bf16x8*)(Kl + l31 * 72 + 16 * s + 8 * hi); sacc = __builtin_amdgcn_mfma_f32_32x32x16_bf16(kf, qf[s], sacc, 0, 0, 0); }
            if (j == 4 * qb + wq) {
                asm volatile("" ::: "memory");
#pragma unroll
                for (int r = 0; r < 16; ++r) { const int kpos = 32 * j + 8 * (r >> 2) + 4 * hi + (r & 3); if (kpos > qp) sacc[r] = -INFINITY; } }
            float tmax = -INFINITY;
#pragma unroll
            for (int r = 0; r < 16; ++r) tmax = fmaxf(tmax, sacc[r]);
            tmax = fmaxf(tmax, __shfl_xor(tmax, 32));
            const float mnew = fmaxf(m, tmax), muse = mnew == -INFINITY ? 0.f : mnew;
            const float alpha = __builtin_amdgcn_exp2f(m - muse);
            m = mnew; lsum *= alpha;
#pragma unroll
            for (int r = 0; r < 16; ++r) { o0[r] *= alpha; o1[r] *= alpha; }
            float ps = 0.f;
#pragma unroll
            for (int r = 0; r < 16; ++r) { const float pv = __builtin_amdgcn_exp2f(sacc[r] - muse); sacc[r] = pv; ps += pv; }
            lsum += ps;
#pragma unroll
            for (int s = 0; s < 2; ++s) {
                u32x4 pw; pw.x = cvt_pk_bf16(sacc[8 * s + 0], sacc[8 * s + 1]); pw.y = cvt_pk_bf16(sacc[8 * s + 2], sacc[8 * s + 3]); pw.z = cvt_pk_bf16(sacc[8 * s + 4], sacc[8 * s + 5]); pw.w = cvt_pk_bf16(sacc[8 * s + 6], sacc[8 * s + 7]);
                const bf16x8 pf = __builtin_bit_cast(bf16x8, pw);
                { const bf16_t* vp = Vt + l31 * 40 + 16 * s + 4 * hi; const u32x2 lo = *(const u32x2*)vp, hi2 = *(const u32x2*)(vp + 8); u32x4 vv; vv.x = lo.x; vv.y = lo.y; vv.z = hi2.x; vv.w = hi2.y;
                  o0 = __builtin_amdgcn_mfma_f32_32x32x16_bf16(__builtin_bit_cast(bf16x8, vv), pf, o0, 0, 0, 0); }
                { const bf16_t* vp = Vt + (32 + l31) * 40 + 16 * s + 4 * hi; const u32x2 lo = *(const u32x2*)vp, hi2 = *(const u32x2*)(vp + 8); u32x4 vv; vv.x = lo.x; vv.y = lo.y; vv.z = hi2.x; vv.w = hi2.y;
                  o1 = __builtin_amdgcn_mfma_f32_32x32x16_bf16(__builtin_bit_cast(bf16x8, vv), pf, o1, 0, 0, 0); }
            }
        }
        }
        __syncthreads();
    }
#undef ATT_LOAD2
#undef ATT_STORE2
    lsum += __shfl_xor(lsum, 32);
    float* cb = comb + (size_t)(wq * 64 + lane) * 34;
    if (g == 1) { cb[0] = m; cb[1] = lsum;
#pragma unroll
        for (int r = 0; r < 16; ++r) { cb[2 + r] = o0[r]; cb[18 + r] = o1[r]; } }
    __syncthreads();
    if (g == 0 && qp >= NPAD && !dry) {
        const float m1 = cb[0], l1 = cb[1];
        const float mf = fmaxf(m, m1), a0 = __builtin_amdgcn_exp2f(m - mf), a1 = __builtin_amdgcn_exp2f(m1 - mf);
        const float inv = 1.0f / (lsum * a0 + l1 * a1);
        bf16_t* op = P + (rowbase + qp) * PP + C_FQ + 64 * hh + 4 * hi;
#pragma unroll
        for (int g4 = 0; g4 < 4; ++g4) {
            u32x2 w0, w1; float t0[4], t1[4];
#pragma unroll
            for (int i = 0; i < 4; ++i) { t0[i] = (o0[4 * g4 + i] * a0 + cb[2 + 4 * g4 + i] * a1) * inv; t1[i] = (o1[4 * g4 + i] * a0 + cb[18 + 4 * g4 + i] * a1) * inv; }
            w0.x = cvt_pk_bf16(t0[0], t0[1]); w0.y = cvt_pk_bf16(t0[2], t0[3]); w1.x = cvt_pk_bf16(t1[0], t1[1]); w1.y = cvt_pk_bf16(t1[2], t1[3]);
            *(u32x2*)(op + 8 * g4) = w0; *(u32x2*)(op + 32 + 8 * g4) = w1;
        }
    }
    __syncthreads();
}
__device__ __forceinline__ void attn_phase(bf16_t* P, const float* CUM, const unsigned* KMAX, unsigned char* lds, const bool dry) {
    const int c = blockIdx.x, G = gridDim.x;
    for (int rd = 0;; ++rd) {
        const int idx = (rd & 1) ? (rd + 1) * G - 1 - c : rd * G + c;
        if (rd * G >= 16 * NCH) break;
        if (idx >= 16 * NCH) continue;
        const int qb = NCH - 1 - idx / 16, bh = idx & 15;
        attn_unit(bh >> 3, bh & 7, qb, P, CUM, KMAX, lds, dry);
    }
}

constexpr int L_CB = 0, L_QT = 32768, L_KT = 51200, L_VT = 69632, L_ST = 104448, L_GAL = 122880;
static_assert(L_GAL + 8192 <= LDS_MAIN, "GLA LDS map");
__device__ __forceinline__ void gla_cb(int b, int hh, int c, const Args& ar, int layer, unsigned char* lds) {
    const int tid = otid(), k = tid & 63, seg = tid >> 6;
    float* CB = (float*)(lds + L_CB); float* SEG = (float*)(lds + L_QT); float* GAL = (float*)(lds + L_GAL);
    const float* GA = (const float*)(ar.ws + WS_GA);
    const size_t r0 = (size_t)b * LP + (size_t)BLK * c;
    *(f32x4*)(GAL + 4 * tid) = *(const f32x4*)(GA + r0 * 16 + 4 * tid);
    float wcol[16];
#pragma unroll
    for (int r = 0; r < 16; ++r) wcol[r] = ar.w_alpha_up[(size_t)layer * 16 * 256 + r * 256 + 64 * hh + k];
    const float bias = ar.b_alpha[layer * 256 + 64 * hh + k];
    __syncthreads();
    float vals[16]; float run = 0.f;
#pragma unroll
    for (int i = 0; i < 16; ++i) { const int t = 16 * seg + i; float x = bias;
#pragma unroll
        for (int r4 = 0; r4 < 4; ++r4) { const f32x4 gv = *(const f32x4*)(GAL + t * 16 + 4 * r4); x += gv[0] * wcol[4 * r4] + gv[1] * wcol[4 * r4 + 1] + gv[2] * wcol[4 * r4 + 2] + gv[3] * wcol[4 * r4 + 3]; }
        const float la = (BLK * c + t >= NPAD) ? logsigmoidf(x) * (1.0f / 16.0f) : 0.f;
        run += la; vals[i] = run; }
    SEG[seg * 64 + k] = run;
    __syncthreads();
    float off = 0.f;
#pragma unroll
    for (int s = 0; s < 8; ++s) off += (s < seg) ? SEG[s * 64 + k] : 0.f;
#pragma unroll
    for (int i = 0; i < 16; ++i) CB[(16 * seg + i) * 64 + k] = vals[i] + off;
    __syncthreads();
}
__device__ __forceinline__ void gla_load_v(u32x4 (&vr)[4], const bf16_t* P, size_t r0, int hh, int tid) {
#pragma unroll
    for (int i = 0; i < 4; ++i) { const int idx = tid + 512 * i, s = idx & 127, c16 = idx >> 7; vr[i] = *(const u32x4*)(P + (r0 + s) * PP + C_GV + 128 * hh + 8 * c16); }
}
__device__ __forceinline__ void gla_store_vt(const u32x4 (&vr)[4], unsigned char* lds, int tid) {
    bf16_t* VT = (bf16_t*)(lds + L_VT);
#pragma unroll
    for (int i = 0; i < 4; ++i) { const int idx = tid + 512 * i, s = idx & 127, c16 = idx >> 7; const u32x4 v = vr[i];
        bf16_t* vt = VT + (8 * c16) * 136 + s;
        vt[0] = (bf16_t)v.x; vt[136] = (bf16_t)(v.x >> 16); vt[272] = (bf16_t)v.y; vt[408] = (bf16_t)(v.y >> 16); vt[544] = (bf16_t)v.z; vt[680] = (bf16_t)(v.z >> 16); vt[816] = (bf16_t)v.w; vt[952] = (bf16_t)(v.w >> 16); }
}
__device__ __forceinline__ void gla_g1_unit(int b, int hh, int c, const Args& ar, int layer, unsigned char* lds) {
    const int tid = otid(), k = tid & 63, seg = tid >> 6, lane = tid & 63, w = tid >> 6, l15 = lane & 15, quad = lane >> 4;
    const bf16_t* P = (const bf16_t*)(ar.ws + WS_R2); float* STG = (float*)(ar.ws + WS_R1); float* DEC = (float*)(ar.ws + WS_DEC);
    const int unit = (b * 4 + hh) * NCH + c; const size_t r0 = (size_t)b * LP + (size_t)BLK * c;
    unsigned short kraw[16]; u32x4 vraw[4];
#pragma unroll
    for (int i = 0; i < 16; ++i) kraw[i] = P[(r0 + 16 * seg + i) * PP + C_GK + 64 * hh + k];
    gla_load_v(vraw, P, r0, hh, tid);
    gla_cb(b, hh, c, ar, layer, lds);
    const float* CB = (const float*)(lds + L_CB); bf16_t* KHT = (bf16_t*)(lds + L_KT); const bf16_t* VT = (const bf16_t*)(lds + L_VT);
    { const float cl = CB[127 * 64 + k]; unsigned pk[8];
#pragma unroll
      for (int i = 0; i < 16; i += 2) { const int t = 16 * seg + i;
          const float k0 = bf2f(kraw[i]) * __expf(cl - CB[t * 64 + k]);
          const float k1 = bf2f(kraw[i + 1]) * __expf(cl - CB[(t + 1) * 64 + k]);
          pk[i >> 1] = cvt_pk_bf16(k0, k1); }
      u32x4 w0, w1; w0.x = pk[0]; w0.y = pk[1]; w0.z = pk[2]; w0.w = pk[3]; w1.x = pk[4]; w1.y = pk[5]; w1.z = pk[6]; w1.w = pk[7];
      *(u32x4*)(KHT + k * 136 + 16 * seg) = w0; *(u32x4*)(KHT + k * 136 + 16 * seg + 8) = w1;
      if (seg == 0) DEC[unit * 64 + k] = __expf(cl); }
    gla_store_vt(vraw, lds, tid);
    __syncthreads();
#pragma unroll
    for (int kt = 0; kt < 4; ++kt) { f32x4 acc = {0.f, 0.f, 0.f, 0.f};
#pragma unroll
        for (int ks = 0; ks < 4; ++ks) { const bf16x8 af = *(const bf16x8*)(KHT + (16 * kt + l15) * 136 + 32 * ks + 8 * quad); const bf16x8 bfr = *(const bf16x8*)(VT + (16 * w + l15) * 136 + 32 * ks + 8 * quad);
            acc = __builtin_amdgcn_mfma_f32_16x16x32_bf16(af, bfr, acc, 0, 0, 0); }
        *(f32x4*)(STG + ((size_t)unit * 128 + 16 * w + l15) * 64 + 16 * kt + 4 * quad) = acc; }
    __syncthreads();
}
__device__ __forceinline__ void gla_g2_phase(const Args& ar) {
    float* STG = (float*)(ar.ws + WS_R1); const float* DEC = (const float*)(ar.ws + WS_DEC);
    const int gid = blockIdx.x * NTHREADS + otid();
    if (gid >= 8 * 8192) return;
    const int bh = gid >> 13, e = gid & 8191, k = e & 63;
    float carry = 0.f;
    float u[13], d[13], un[13], dn[13];
#pragma unroll
    for (int i = 0; i < 13; ++i) { const int unit = bh * NCH + i; u[i] = STG[(size_t)unit * 8192 + e]; d[i] = DEC[unit * 64 + k]; }
#pragma unroll 1
    for (int c0 = 0; c0 < NCH; c0 += 13) {
        if (c0 + 13 < NCH) {
#pragma unroll
            for (int i = 0; i < 13; ++i) { const int unit = bh * NCH + c0 + 13 + i; un[i] = STG[(size_t)unit * 8192 + e]; dn[i] = DEC[unit * 64 + k]; } }
#pragma unroll
        for (int i = 0; i < 13; ++i) { const int unit = bh * NCH + c0 + i; STG[(size_t)unit * 8192 + e] = carry; carry = d[i] * carry + u[i]; }
#pragma unroll
        for (int i = 0; i < 13; ++i) { u[i] = un[i]; d[i] = dn[i]; }
    }
}
__device__ __forceinline__ void gla_g3_unit(int b, int hh, int c, const Args& ar, int layer, unsigned char* lds, const bool dry) {
    const int tid = otid(), k = tid & 63, seg = tid >> 6, lane = tid & 63, w = tid >> 6, l15 = lane & 15, quad = lane >> 4;
    bf16_t* P = (bf16_t*)(ar.ws + WS_R2); const float* STG = (const float*)(ar.ws + WS_R1);
    const int unit = (b * 4 + hh) * NCH + c; const size_t r0 = (size_t)b * LP + (size_t)BLK * c;
    unsigned short qraw[16], kraw[16]; float sraw[16]; u32x4 vraw[4];
#pragma unroll
    for (int i = 0; i < 16; ++i) { const bf16_t* pp = P + (r0 + 16 * seg + i) * PP + 64 * hh + k; qraw[i] = pp[C_GQ]; kraw[i] = pp[C_GK]; }
#pragma unroll
    for (int i = 0; i < 16; ++i) sraw[i] = c == 0 ? 0.f : STG[((size_t)unit * 128 + seg + 8 * i) * 64 + k];
    gla_load_v(vraw, P, r0, hh, tid);
    u32x2 grraw[8];
    { const bf16_t* gp = P + (r0 + 16 * w + l15) * PP + C_GR + 128 * hh + 4 * quad;
#pragma unroll
      for (int vt = 0; vt < 8; ++vt) grraw[vt] = *(const u32x2*)(gp + 16 * vt); }
    gla_cb(b, hh, c, ar, layer, lds);
    const float* CB = (const float*)(lds + L_CB); bf16_t* QT = (bf16_t*)(lds + L_QT); bf16_t* KT = (bf16_t*)(lds + L_KT); const bf16_t* VT = (const bf16_t*)(lds + L_VT); bf16_t* ST = (bf16_t*)(lds + L_ST);
    const float ref = CB[63 * 64 + k];
    __syncthreads();
#pragma unroll
    for (int i = 0; i < 16; ++i) { const int t = 16 * seg + i; const float cbv = CB[t * 64 + k];
        const float qv = bf2f(qraw[i]) * __expf(cbv - ref);
        const float kv = bf2f(kraw[i]) * __expf(ref - cbv);
        QT[t * 72 + k] = (bf16_t)(cvt_pk_bf16(qv, 0.f)); KT[t * 72 + k] = (bf16_t)(cvt_pk_bf16(kv, 0.f)); }
    { const float er = __expf(ref);
#pragma unroll
      for (int i = 0; i < 16; ++i) { const int v = seg + 8 * i; ST[v * 72 + k] = (bf16_t)cvt_pk_bf16(sraw[i] * er, 0.f); } }
    gla_store_vt(vraw, lds, tid);
    __syncthreads();
    f32x4 acc[8];
#pragma unroll
    for (int vt = 0; vt < 8; ++vt) acc[vt] = (f32x4){0.f, 0.f, 0.f, 0.f};
    bf16x8 bq[2];
#pragma unroll
    for (int ks = 0; ks < 2; ++ks) bq[ks] = *(const bf16x8*)(QT + (16 * w + l15) * 72 + 32 * ks + 8 * quad);
#pragma unroll
    for (int ks = 0; ks < 2; ++ks)
#pragma unroll
        for (int vt = 0; vt < 8; ++vt) { const bf16x8 af = *(const bf16x8*)(ST + (16 * vt + l15) * 72 + 32 * ks + 8 * quad); acc[vt] = __builtin_amdgcn_mfma_f32_16x16x32_bf16(af, bq[ks], acc[vt], 0, 0, 0); }
    const int npairs = (w >> 1) + 1, tq = 16 * w + l15;
    for (int pr = 0; pr < npairs; ++pr) {
        f32x4 x0 = {0.f, 0.f, 0.f, 0.f}, x1 = x0;
#pragma unroll
        for (int ks = 0; ks < 2; ++ks) { const bf16x8 a0 = *(const bf16x8*)(KT + (32 * pr + l15) * 72 + 32 * ks + 8 * quad); const bf16x8 a1 = *(const bf16x8*)(KT + (32 * pr + 16 + l15) * 72 + 32 * ks + 8 * quad);
            x0 = __builtin_amdgcn_mfma_f32_16x16x32_bf16(a0, bq[ks], x0, 0, 0, 0); x1 = __builtin_amdgcn_mfma_f32_16x16x32_bf16(a1, bq[ks], x1, 0, 0, 0); }
#pragma unroll
        for (int j = 0; j < 4; ++j) { const int s0 = 32 * pr + 4 * quad + j; if (s0 > tq) x0[j] = 0.f; if (s0 + 16 > tq) x1[j] = 0.f; }
        u32x4 pw; pw.x = cvt_pk_bf16(x0[0], x0[1]); pw.y = cvt_pk_bf16(x0[2], x0[3]); pw.z = cvt_pk_bf16(x1[0], x1[1]); pw.w = cvt_pk_bf16(x1[2], x1[3]);
        const bf16x8 pf = __builtin_bit_cast(bf16x8, pw);
#pragma unroll
        for (int vt = 0; vt < 8; ++vt) { const bf16_t* vp = VT + (16 * vt + l15) * 136 + 32 * pr + 4 * quad; const u32x2 lo = *(const u32x2*)vp, hi2 = *(const u32x2*)(vp + 16);
            u32x4 vv; vv.x = lo.x; vv.y = lo.y; vv.z = hi2.x; vv.w = hi2.y;
            acc[vt] = __builtin_amdgcn_mfma_f32_16x16x32_bf16(__builtin_bit_cast(bf16x8, vv), pf, acc[vt], 0, 0, 0); }
    }
    float ss = 0.f;
#pragma unroll
    for (int vt = 0; vt < 8; ++vt) ss += acc[vt][0] * acc[vt][0] + acc[vt][1] * acc[vt][1] + acc[vt][2] * acc[vt][2] + acc[vt][3] * acc[vt][3];
    ss += __shfl_xor(ss, 16); ss += __shfl_xor(ss, 32);
    const float rs = rsqrtf(ss * (1.0f / 128.0f) + RMS_EPS);
    const float* gg = ar.g_gla_out + layer * 512 + 128 * hh;
    bf16_t* op = P + (r0 + tq) * PP + C_GR + 128 * hh + 4 * quad;
#pragma unroll
    for (int vt = 0; vt < 8; ++vt) { const u32x2 gr = grraw[vt]; const f32x4 g4 = *(const f32x4*)(gg + 16 * vt + 4 * quad);
        const float r0v = __uint_as_float(gr.x << 16), r1v = __uint_as_float(gr.x & 0xffff0000u), r2v = __uint_as_float(gr.y << 16), r3v = __uint_as_float(gr.y & 0xffff0000u);
        u32x2 wv; wv.x = cvt_pk_bf16(acc[vt][0] * rs * g4[0] * r0v, acc[vt][1] * rs * g4[1] * r1v); wv.y = cvt_pk_bf16(acc[vt][2] * rs * g4[2] * r2v, acc[vt][3] * rs * g4[3] * r3v);
        if (!dry) *(u32x2*)(op + 16 * vt) = wv; }
    __syncthreads();
}


constexpr int MAIN_ROWS = 64 * 256;
template <int EPI, int NS>
__device__ __forceinline__ void thin_gemm(const bf16_t* A, int lda, const bf16_t* Bt, int K, bf16_t* O, int ldc, bf16_t* P, unsigned char* lds) {
    const int tid = otid(), lane = tid & 63, w = tid >> 6, l31 = lane & 31, hi = lane >> 5;
    float* red = (float*)lds;
    for (int piece = blockIdx.x; piece < 256; piece += gridDim.x) {
        const int m0 = MAIN_ROWS + 32 * (piece >> 5), n0 = 32 * (piece & 31);
        const int kw = K >> 3, kb = w * kw;
        const bf16_t* ap = A + (size_t)(m0 + l31) * lda + kb + 8 * hi;
        const bf16_t* bp = Bt + (size_t)(n0 + l31) * K + kb + 8 * hi;
        f32x16 acc;
#pragma unroll
        for (int r = 0; r < 16; ++r) acc[r] = 0.f;
        bf16x8 wfr[NS], afr[NS];
#pragma unroll
        for (int s = 0; s < NS; ++s) { wfr[s] = *(const bf16x8*)(bp + 16 * s); afr[s] = *(const bf16x8*)(ap + 16 * s); }
#pragma unroll
        for (int s = 0; s < NS; ++s) acc = __builtin_amdgcn_mfma_f32_32x32x16_bf16(wfr[s], afr[s], acc, 0, 0, 0);
#pragma unroll
        for (int r = 0; r < 16; ++r) red[(w * 16 + r) * 64 + lane] = acc[r];
        __syncthreads();
        float v0 = 0.f, v1 = 0.f;
#pragma unroll
        for (int ww = 0; ww < 8; ++ww) { v0 += red[(ww * 16 + 2 * w) * 64 + lane]; v1 += red[(ww * 16 + 2 * w + 1) * 64 + lane]; }
        const int m = m0 + l31, n = n0 + ((2 * w) & 3) + 8 * ((2 * w) >> 2) + 4 * hi;
        if (EPI == 0) { *(unsigned*)(O + (size_t)m * ldc + n) = cvt_pk_bf16(v0, v1); }
        else { bf16_t* rowp = P + (size_t)m * PP + n; const unsigned gq = *(const unsigned*)(rowp + (EPI == 1 ? C_GTA : C_GTB));
            const float g0 = __uint_as_float(gq << 16), g1 = __uint_as_float(gq & 0xffff0000u);
            float t0 = 0.f, t1 = 0.f; if (EPI == 2) { const unsigned tq = *(const unsigned*)(rowp + C_YM); t0 = __uint_as_float(tq << 16); t1 = __uint_as_float(tq & 0xffff0000u); }
            *(unsigned*)(rowp + C_YM) = cvt_pk_bf16(t0 + v0 * g0, t1 + v1 * g1); }
        __syncthreads();
    }
}

#define XB_TMO      128
#define XB_XCNT(j)  (256  + 64 * (j))
#define XB_XSUB(j)  (1280 + 64 * (j))
#define XB_XGEN(j)  (2304 + 64 * (j))
#define XB_TOP      3328
#define XB_TOPGEN   3392
#define XCD_BAR_WORDS 3456
#define XB_SPIN_CAP (1u << 18)
#define LAS __attribute__((address_space(3)))

__device__ __forceinline__ unsigned xb_ld(unsigned* p)              { return __hip_atomic_load(p, __ATOMIC_RELAXED, __HIP_MEMORY_SCOPE_AGENT); }
__device__ __forceinline__ unsigned xb_add(unsigned* p, unsigned v) { return __hip_atomic_fetch_add(p, v, __ATOMIC_RELAXED, __HIP_MEMORY_SCOPE_AGENT); }
__device__ __forceinline__ unsigned xb_xcc_id() { return (unsigned)__builtin_amdgcn_s_getreg((3 << 11) | 20) & 0xFu; }
#define XB_SPIN(cond, bar) do { unsigned _sp = 0; while (cond) { __builtin_amdgcn_s_sleep(1); \
    if ((++_sp & 255u) == 0u) { if (xb_ld(&(bar)[XB_TMO])) break; if (_sp > XB_SPIN_CAP) { atomicAdd(&(bar)[XB_TMO], 1u); break; } } } } while (0)

struct XcdBarrier {
    unsigned* bar; unsigned x;
    volatile LAS unsigned* st;
};

__device__ __forceinline__ XcdBarrier xcd_barrier_post(unsigned* bar, volatile LAS unsigned* st) {
    XcdBarrier b; b.bar = bar; b.x = xb_xcc_id(); b.st = st;
    if (threadIdx.x == 0) (void)xb_add(&bar[XB_XCNT(b.x)], 1u);
    return b;
}
__device__ __forceinline__ void xcd_barrier_complete(unsigned* bar, unsigned x, unsigned& nloc, unsigned& nx) {
    const unsigned G = gridDim.x * gridDim.y * gridDim.z;
    unsigned sum, cnt, mine, sp = 0u;
    for (;;) {
        sum = 0u; cnt = 0u; mine = 0u;
#pragma unroll
        for (unsigned j = 0; j < 16; ++j) { const unsigned c = xb_ld(&bar[XB_XCNT(j)]); sum += c; cnt += (c > 0u) ? 1u : 0u; mine = (j == x) ? c : mine; }
        if (sum == G) break;
        __builtin_amdgcn_s_sleep(1);
        if ((++sp & 255u) == 0u) { if (xb_ld(&bar[XB_TMO])) break; if (sp > XB_SPIN_CAP) { atomicAdd(&bar[XB_TMO], 1u); break; } }
    }
    nloc = mine > 0u ? mine : 1u; nx = cnt > 0u ? cnt : 1u;
}

__device__ __forceinline__ void xcd_barrier(const XcdBarrier& b) {
    asm volatile("s_waitcnt vmcnt(0)" ::: "memory");
    __syncthreads();
    if (threadIdx.x == 0) {
        unsigned* bar = b.bar;
        __builtin_amdgcn_s_waitcnt(0);
        unsigned nloc = b.st[0], nx = b.st[1];
        if (nloc == 0u) { xcd_barrier_complete(bar, b.x, nloc, nx); b.st[0] = nloc; b.st[1] = nx; }
        const unsigned old = xb_add(&bar[XB_XSUB(b.x)], 1u);
        const unsigned gen = old / nloc;
        if (old + 1u == (gen + 1u) * nloc) {
            __builtin_amdgcn_fence(__ATOMIC_RELEASE, "agent");
            asm volatile("s_waitcnt vmcnt(0)" ::: "memory");
            const unsigned og = xb_add(&bar[XB_TOP], 1u);
            const unsigned tg = og / nx;
            if (og + 1u == (tg + 1u) * nx) xb_add(&bar[XB_TOPGEN], 1u);
            else XB_SPIN(xb_ld(&bar[XB_TOPGEN]) == tg, bar);
            __builtin_amdgcn_fence(__ATOMIC_ACQUIRE, "agent");
            xb_add(&bar[XB_XGEN(b.x)], 1u);
            asm volatile("s_waitcnt vmcnt(0)" ::: "memory");
        } else {
            XB_SPIN(xb_ld(&bar[XB_XGEN(b.x)]) == gen, bar);
            __builtin_amdgcn_fence(__ATOMIC_ACQUIRE, "agent");
            asm volatile("s_waitcnt vmcnt(0)" ::: "memory");
        }
    }
    __syncthreads();
}


__global__ void __launch_bounds__(NTHREADS, 2) fwd_megakernel(Args ar) {
    extern __shared__ __attribute__((aligned(16))) unsigned char lds[];
    cg::grid_group grid = cg::this_grid();
    if (gridDim.x == 0x7fffffffu) grid.sync();
    { const int t0_ = otid(); if (t0_ < 4) ((PG8_LAS unsigned*)(lds + LDS_MAIN))[t0_] = 0u; }
    __syncthreads();
    const XcdBarrier xbar = xcd_barrier_post((unsigned*)(ar.ws + WS_BAR), (volatile LAS unsigned*)(PG8_LAS unsigned*)(lds + LDS_MAIN));
#ifdef PROBE_SYNC
#define GSYNC() do { xcd_barrier(xbar); xcd_barrier(xbar); } while (0)
#else
#define GSYNC() xcd_barrier(xbar)
#endif
    PG8_LAS unsigned char* lds3 = (PG8_LAS unsigned char*)lds;
    unsigned char* ws = ar.ws;
    bf16_t* R1 = (bf16_t*)(ws + WS_R1); bf16_t* R2 = (bf16_t*)(ws + WS_R2);
    float* LF = (float*)(ws + WS_LF); float* GA = (float*)(ws + WS_GA); float* CUM = (float*)(ws + WS_CUM); unsigned* KMAXW = (unsigned*)(ws + WS_KMAX);
    const int G = gridDim.x, cblk = blockIdx.x;

#pragma unroll 1
    for (int it = 0; it <= DEPTH; ++it) {
      const int layer = it - 1;
      if (layer >= 0) {
#pragma unroll 1
        for (int ffn = 0; ffn < 2; ++ffn) {
            if (ffn == 1) {
                { const int t0_ = otid(); if (cblk == 0 && t0_ < 16) KMAXW[t0_] = 0u; }
                { pg8::Gemm g{R1, (const bf16_t*)(ws + WS_WIN), MR, NINP, DM, DM}; pg8::StaticOrder S; S.init(MR, NINP, G, cblk);
                  pg8::EpiInProj E{R2, LF, GA, ar.b_f + layer * 8};
                  pg8::gemm_phase<pg8::EpiInProj, pg8::StaticOrder, true, true>(lds3, g, S, E); }
                GSYNC();
                cumsum_phase(LF, CUM, lds);
                kmax_phase(R2, KMAXW, lds);
                for (int u = cblk; u < 8 * 64; u += G) gla_g1_unit(u >> 8, (u >> 6) & 3, u & 63, ar, layer, lds);
#ifdef PROBE_G1
                for (int u = cblk; u < 8 * 64; u += G) gla_g1_unit(u >> 8, (u >> 6) & 3, u & 63, ar, layer, lds);
#endif
                GSYNC();
                gla_g2_phase(ar);
                if (G >= 136) { if (cblk >= 128 && cblk < 136) gla_g3_unit((cblk - 128) >> 2, (cblk - 128) & 3, 0, ar, layer, lds, false); }
                else if (cblk == 0) { for (int u = 0; u < 8; ++u) gla_g3_unit(u >> 2, u & 3, 0, ar, layer, lds, false); }
#ifdef PROBE_ATTN
                attn_phase(R2, CUM, KMAXW, lds, true);
#endif
                attn_phase(R2, CUM, KMAXW, lds, false);
                GSYNC();
#ifdef PROBE_G3
                for (int u = cblk; u < 8 * 64; u += G) gla_g3_unit(u >> 8, (u >> 6) & 3, 1 + (u & 63), ar, layer, lds, true);
#endif
                for (int u = cblk; u < 8 * 64; u += G) gla_g3_unit(u >> 8, (u >> 6) & 3, 1 + (u & 63), ar, layer, lds, false);
                { pg8::Gemm g{R2 + C_FQ, (const bf16_t*)(ws + WS_WFO), MAIN_ROWS, DM, 512, PP}; pg8::StaticOrder S; S.init(MAIN_ROWS, DM, G, cblk);
                  pg8::EpiMerge1 E{R2};
                  pg8::gemm_phase<pg8::EpiMerge1, pg8::StaticOrder, true, true>(lds3, g, S, E); }
                thin_gemm<1, 4>(R2 + C_FQ, PP, (const bf16_t*)(ws + WS_WFO), 512, nullptr, 0, R2, lds);
                GSYNC();
                { pg8::Gemm g{R2 + C_GR, (const bf16_t*)(ws + WS_WGO), MAIN_ROWS, DM, 512, PP}; pg8::StaticOrder S; S.init(MAIN_ROWS, DM, G, cblk);
                  pg8::EpiMerge2 E{R2};
                  pg8::gemm_phase<pg8::EpiMerge2, pg8::StaticOrder, true, true>(lds3, g, S, E); }
                thin_gemm<2, 4>(R2 + C_GR, PP, (const bf16_t*)(ws + WS_WGO), 512, nullptr, 0, R2, lds);
                GSYNC();
                { pg8::Gemm g{R2 + C_YM, (const bf16_t*)(ws + WS_WOUT), MAIN_ROWS, DM, DM, PP}; pg8::StaticOrder S; S.init(MAIN_ROWS, DM, G, cblk);
                  pg8::EpiPlain E{R1, DM};
                  pg8::gemm_phase<pg8::EpiPlain, pg8::StaticOrder, true, true>(lds3, g, S, E); }
                thin_gemm<0, 8>(R2 + C_YM, PP, (const bf16_t*)(ws + WS_WOUT), DM, R1, DM, nullptr, lds);
                GSYNC();
#ifdef PROBE_NORM
                norm_phase<1>(ar, R1, R1, 1.0f, ar.g_postm + layer * DM, ar.g_pre2 + layer * DM, true);
#endif
                norm_phase<1>(ar, R1, R1, 1.0f, ar.g_postm + layer * DM, ar.g_pre2 + layer * DM);
                GSYNC();
            }
            { pg8::Gemm g{R1, (const bf16_t*)(ws + (ffn ? WS_WGU2 : WS_WGU1)), MR, NGU, DM, DM}; pg8::StaticOrder S; S.init(MR, NGU, G, cblk);
              pg8::EpiSwiglu E{R2, DFF};
              pg8::gemm_phase<pg8::EpiSwiglu, pg8::StaticOrder, true, true>(lds3, g, S, E);
#ifdef PROBE_GU
              __syncthreads(); pg8::gemm_phase<pg8::EpiSwiglu, pg8::StaticOrder, true, true>(lds3, g, S, E);
#endif
            }
            GSYNC();
            { pg8::Gemm g{R2, (const bf16_t*)(ws + (ffn ? WS_WD2 : WS_WD1)), MAIN_ROWS, DM, DFF, DFF}; pg8::StaticOrder S; S.init(MAIN_ROWS, DM, G, cblk);
              pg8::EpiPlain E{R1, DM};
              pg8::gemm_phase<pg8::EpiPlain, pg8::StaticOrder, true, true>(lds3, g, S, E);
#ifdef PROBE_DOWN
              __syncthreads(); pg8::gemm_phase<pg8::EpiPlain, pg8::StaticOrder, true, true>(lds3, g, S, E);
#endif
            }
            thin_gemm<0, 22>(R2, DFF, (const bf16_t*)(ws + (ffn ? WS_WD2 : WS_WD1)), DFF, R1, DM, nullptr, lds);
#ifdef PROBE_THIN
            thin_gemm<0, 22>(R2, DFF, (const bf16_t*)(ws + (ffn ? WS_WD2 : WS_WD1)), DFF, R1, DM, nullptr, lds);
#endif
            GSYNC();
#ifdef PROBE_NORM
            norm_phase<1>(ar, R1, R1, 0.5f, ar.g_post1 + layer * DM, ar.g_prem + layer * DM, true);
#endif
            if (ffn == 0) norm_phase<1>(ar, R1, R1, 0.5f, ar.g_post1 + layer * DM, ar.g_prem + layer * DM);
            else norm_phase<1>(ar, R1, R1, 0.5f, ar.g_post2 + layer * DM, layer + 1 < DEPTH ? ar.g_pre1 + (layer + 1) * DM : nullptr);
            if (ffn == 0) GSYNC();
        }
      }
      if (it < DEPTH) convert_phase(ar, it, lds);
      if (it == 0) norm_phase<0>(ar, nullptr, R1, 0.f, nullptr, ar.g_pre1);
      if (it < DEPTH) GSYNC();
    }
}

extern "C" void kernel_launch(void* const* d_in, const int* in_sizes, int n_in, void* d_out, int out_size, void* d_ws, size_t ws_size, hipStream_t stream) {
    static int grid = 0;
    if (grid == 0) {
        if (n_in != 20 || out_size != NB * SEQ * DM || ws_size < WS_END) { fprintf(stderr, "kernel_launch: unexpected shapes (n_in %d, out %d, ws %zu < %zu); nothing launched\n", n_in, out_size, ws_size, (size_t)WS_END); grid = -1; return; }
        int dev = 0, cus = 0, per_cu = 0;
        hipGetDevice(&dev); hipDeviceGetAttribute(&cus, hipDeviceAttributeMultiprocessorCount, dev);
        if (hipFuncSetAttribute((const void*)fwd_megakernel, hipFuncAttributeMaxDynamicSharedMemorySize, LDS_BYTES) != hipSuccess) { fprintf(stderr, "kernel_launch: hipFuncSetAttribute failed\n"); grid = -1; return; }
        if (hipOccupancyMaxActiveBlocksPerMultiprocessor(&per_cu, (const void*)fwd_megakernel, NTHREADS, LDS_BYTES) != hipSuccess || per_cu < 1) per_cu = 1;
        (void)hipGetLastError();
        grid = cus > 0 ? cus : 256;
    }
    if (grid < 0) return;
    Args a{};
    const float* const* in = (const float* const*)d_in;
    a.x = in[0]; a.meta = in[1]; a.w_in = in[2]; a.w_alpha_up = in[3]; a.b_alpha = in[4]; a.b_f = in[5]; a.g_gla_out = in[6]; a.w_fox_o = in[7]; a.w_gla_o = in[8]; a.w_out = in[9];
    a.w_gu1 = in[10]; a.w_d1 = in[11]; a.w_gu2 = in[12]; a.w_d2 = in[13]; a.g_pre1 = in[14]; a.g_post1 = in[15]; a.g_prem = in[16]; a.g_postm = in[17]; a.g_pre2 = in[18]; a.g_post2 = in[19];
    a.out = (float*)d_out; a.ws = (unsigned char*)d_ws;
    if (hipMemsetAsync((unsigned char*)d_ws + WS_BAR, 0, 16384, stream) != hipSuccess) { fprintf(stderr, "kernel_launch: memset of the barrier words failed\n"); return; }
    void* args[] = {&a};
    hipError_t e = hipLaunchCooperativeKernel((const void*)fwd_megakernel, dim3(grid), dim3(NTHREADS), args, LDS_BYTES, stream);
    if (e != hipSuccess) fprintf(stderr, "cooperative launch failed: %s (grid %d)\n", hipGetErrorString(e), grid);
}
```

```cpp
#include <hip/hip_runtime.h>
#include <hip/hip_cooperative_groups.h>
#include <cstdio>
#include <cstdint>
namespace cg = cooperative_groups;

constexpr int DM = 1024, NB = 2, SEQ = 8192, DEPTH = 2, NMETA = 16, BLK = 128, NPAD = 112;
constexpr int LP = SEQ + BLK;
constexpr int MR = NB * LP;
constexpr int DFF = 2816, NGU = 2 * DFF;
constexpr int NIN = 5144, NINP = 5376;
constexpr int PP = 5120;
constexpr int C_FQ = 0, C_FK = 512, C_FV = 1024, C_GQ = 1536, C_GK = 1792, C_GV = 2048, C_GR = 2560, C_GTA = 3072, C_GTB = 4096, C_YM = 512;
constexpr int NCH = LP / BLK;
constexpr float RMS_EPS = 1e-6f;
constexpr float LOG2E = 1.4426950408889634f;
constexpr float QSCALE = 0.125f * LOG2E;
namespace pg8 {
#define PG8_LAS __attribute__((address_space(3)))
typedef unsigned short bf16_t;
typedef short bf16x8 __attribute__((ext_vector_type(8)));
typedef float f32x4 __attribute__((ext_vector_type(4)));
typedef unsigned u32x4 __attribute__((ext_vector_type(4)));
constexpr int BM = 256, BK = 64, HALF = 128, HTB = HALF * BK * 2  , STAGE_BYTES = 8 * HTB, NXCD = 8, WGM = 8;

__host__ __device__ __forceinline__ int lds_byte(int r, int c) { const int st = (r >> 4) * 2 + (c >> 5), rr = r & 15, cc = c & 31, ob = rr * 64 + cc * 2; return st * 1024 + (ob ^ (((ob >> 9) & 1) << 5)); }
__host__ __device__ __forceinline__ void stage_rc(int b, int& R, int& C) { const int st = b / 1024, sb = b % 1024, swz = sb ^ (((sb >> 9) & 1) << 5); R = (st >> 1) * 16 + swz / 64; C = (st & 1) * 32 + (swz % 64) / 2; }
__host__ __device__ __forceinline__ int perm32(int rho) { const int n = rho >> 4, i = rho & 15; return 8 * (i >> 2) + 4 * n + (i & 3); }

struct Unit { int pm, pn; };
struct Gemm { const bf16_t* A; const bf16_t* Bt; int M, N, K, lda; };

struct StaticOrder {
    int nM, nN, nwg, G, c;
    __host__ __device__ void init(int M, int N, int G_, int c_) { nM = M / BM; nN = N / BM; nwg = nM * nN; G = G_; c = c_; }
    __host__ __device__ bool next(int i, Unit& u) const {
        const long L = (long)i * G + c; if (L >= nwg) return false;
        int wgid = (int)L; { const int q = nwg / NXCD, r = nwg % NXCD, xcd = wgid % NXCD, off = wgid / NXCD; wgid = (xcd < r ? xcd * (q + 1) : r * (q + 1) + (xcd - r) * q) + off; }
        const int nig = WGM * nN, gid = wgid / nig, fm = gid * WGM, gsz = (nM - fm) < WGM ? (nM - fm) : WGM;
        u.pm = fm + ((wgid % nig) % gsz); u.pn = (wgid % nig) / gsz; return true;
    }
    __device__ __forceinline__ void a_ready(const Unit&) const {}
    __device__ __forceinline__ void done(const Unit&) const {}
};

__device__ __forceinline__ unsigned cvt_pk_bf16(float lo, float hi) { unsigned r; asm volatile("v_cvt_pk_bf16_f32 %0, %1, %2" : "=v"(r) : "v"(lo), "v"(hi)); return r; }
typedef float f32x2 __attribute__((ext_vector_type(2)));
__device__ __forceinline__ float bf2f(unsigned short v) { return __uint_as_float(((unsigned)v) << 16); }
__device__ __forceinline__ float fsigmoid(float x) { return __builtin_amdgcn_rcpf(1.0f + __expf(-x)); }
__device__ __forceinline__ float fsilu(float x) { return x * fsigmoid(x); }
__device__ __forceinline__ float logsigmoidf(float x) { return fminf(x, 0.f) - __logf(1.0f + __expf(-fabsf(x))); }
__device__ __forceinline__ u32x4 pack8(const f32x4 v0, const f32x4 v1) { u32x4 w; w.x = cvt_pk_bf16(v0[0], v0[1]); w.y = cvt_pk_bf16(v0[2], v0[3]); w.z = cvt_pk_bf16(v1[0], v1[1]); w.w = cvt_pk_bf16(v1[2], v1[3]); return w; }
__device__ __forceinline__ void unpack8(const u32x4 w, f32x4& v0, f32x4& v1) {
    v0[0] = __uint_as_float(w.x << 16); v0[1] = __uint_as_float(w.x & 0xffff0000u); v0[2] = __uint_as_float(w.y << 16); v0[3] = __uint_as_float(w.y & 0xffff0000u);
    v1[0] = __uint_as_float(w.z << 16); v1[1] = __uint_as_float(w.z & 0xffff0000u); v1[2] = __uint_as_float(w.w << 16); v1[3] = __uint_as_float(w.w & 0xffff0000u); }

struct EpiPlain {
    static constexpr bool PERM = true, AFTER_DRAIN = false;
    bf16_t* O; int ldc;
    __device__ __forceinline__ void operator()(const f32x4 (&acc)[2][2][4][2], const Unit& u, int wr, int wc, int fr, int fq) const {
        const int row0 = u.pm * BM + wr * 64 + fr, col0 = u.pn * BM + wc * 32 + 8 * fq;
#pragma unroll
        for (int ai = 0; ai < 2; ++ai)
#pragma unroll
            for (int m = 0; m < 4; ++m) { bf16_t* rowp = O + (size_t)(row0 + ai * HALF + m * 16) * ldc + col0;
#pragma unroll
                for (int bj = 0; bj < 2; ++bj) *(u32x4*)(rowp + bj * HALF) = pack8(acc[ai][bj][m][0], acc[ai][bj][m][1]); }
    }
};
struct EpiSwiglu {
    static constexpr bool PERM = true, AFTER_DRAIN = false;
    bf16_t* O; int ldc;
    __device__ __forceinline__ void operator()(const f32x4 (&acc)[2][2][4][2], const Unit& u, int wr, int wc, int fr, int fq) const {
        const int row0 = u.pm * BM + wr * 64 + fr, col0 = u.pn * HALF + wc * 32 + 8 * fq;
#pragma unroll
        for (int ai = 0; ai < 2; ++ai)
#pragma unroll
            for (int m = 0; m < 4; ++m) { bf16_t* rowp = O + (size_t)(row0 + ai * HALF + m * 16) * ldc + col0;
                f32x4 o0, o1;
#pragma unroll
                for (int i = 0; i < 4; ++i) { o0[i] = fsilu(acc[ai][0][m][0][i]) * acc[ai][1][m][0][i]; o1[i] = fsilu(acc[ai][0][m][1][i]) * acc[ai][1][m][1][i]; }
                *(u32x4*)rowp = pack8(o0, o1); }
    }
};
struct EpiInProj {
    static constexpr bool PERM = true, AFTER_DRAIN = false;
    bf16_t* P; float* LF; float* GA; const float* b_f;
    __device__ __forceinline__ void operator()(const f32x4 (&acc)[2][2][4][2], const Unit& u, int wr, int wc, int fr, int fq) const {
        const int pn = u.pn; const int row0 = u.pm * BM + wr * 64 + fr;
        if (pn < 20) {
            const int mode = pn < 2 ? 1 : (pn == 6 ? 1 : (pn < 10 ? 0 : (pn < 12 ? 2 : 3)));
            const float sc = pn < 2 ? QSCALE : 0.125f;
            const int col0 = pn * BM + wc * 32 + 8 * fq;
#pragma unroll
            for (int ai = 0; ai < 2; ++ai)
#pragma unroll
                for (int m = 0; m < 4; ++m) { bf16_t* rowp = P + (size_t)(row0 + ai * HALF + m * 16) * PP + col0;
#pragma unroll
                    for (int bj = 0; bj < 2; ++bj) { f32x4 v0 = acc[ai][bj][m][0], v1 = acc[ai][bj][m][1];
                        if (mode == 1) { v0 = v0 * sc; v1 = v1 * sc; }
                        else if (mode == 2) {
#pragma unroll
                            for (int i = 0; i < 4; ++i) { v0[i] = fsilu(v0[i]); v1[i] = fsilu(v1[i]); } }
                        else if (mode == 3) {
#pragma unroll
                            for (int i = 0; i < 4; ++i) { v0[i] = fsigmoid(v0[i]); v1[i] = fsigmoid(v1[i]); } }
                        *(u32x4*)(rowp + bj * HALF) = pack8(v0, v1); } }
        } else if (wc == 0 && fq < 3) {
#pragma unroll
            for (int ai = 0; ai < 2; ++ai)
#pragma unroll
                for (int m = 0; m < 4; ++m) { const int r = row0 + ai * HALF + m * 16; const int p = r >= LP ? r - LP : r;
                    f32x4 v0 = acc[ai][0][m][0], v1 = acc[ai][0][m][1];
                    if (fq == 0) { const float valid = p >= NPAD ? 1.f : 0.f;
#pragma unroll
                        for (int i = 0; i < 4; ++i) { v0[i] = logsigmoidf(v0[i] + b_f[i]) * valid; v1[i] = logsigmoidf(v1[i] + b_f[4 + i]) * valid; }
                        *(f32x4*)(LF + (size_t)r * 8) = v0; *(f32x4*)(LF + (size_t)r * 8 + 4) = v1;
                    } else { float* g = GA + (size_t)r * 16 + 8 * (fq - 1); *(f32x4*)g = v0; *(f32x4*)(g + 4) = v1; } }
        }
    }
};
struct EpiMerge1 {
    static constexpr bool PERM = true, AFTER_DRAIN = false;
    bf16_t* P;
    __device__ __forceinline__ void operator()(const f32x4 (&acc)[2][2][4][2], const Unit& u, int wr, int wc, int fr, int fq) const {
        const int row0 = u.pm * BM + wr * 64 + fr, col0 = u.pn * BM + wc * 32 + 8 * fq;
#pragma unroll
        for (int ai = 0; ai < 2; ++ai)
#pragma unroll
            for (int m = 0; m < 4; ++m) { bf16_t* rowp = P + (size_t)(row0 + ai * HALF + m * 16) * PP + col0;
#pragma unroll
                for (int bj = 0; bj < 2; ++bj) { f32x4 g0, g1; unpack8(*(const u32x4*)(rowp + C_GTA + bj * HALF), g0, g1);
                    *(u32x4*)(rowp + C_YM + bj * HALF) = pack8(acc[ai][bj][m][0] * g0, acc[ai][bj][m][1] * g1); } }
    }
};
struct EpiMerge2 {
    static constexpr bool PERM = true, AFTER_DRAIN = false;
    bf16_t* P;
    __device__ __forceinline__ void operator()(const f32x4 (&acc)[2][2][4][2], const Unit& u, int wr, int wc, int fr, int fq) const {
        const int row0 = u.pm * BM + wr * 64 + fr, col0 = u.pn * BM + wc * 32 + 8 * fq;
#pragma unroll
        for (int ai = 0; ai < 2; ++ai)
#pragma unroll
            for (int m = 0; m < 4; ++m) { bf16_t* rowp = P + (size_t)(row0 + ai * HALF + m * 16) * PP + col0;
#pragma unroll
                for (int bj = 0; bj < 2; ++bj) { f32x4 g0, g1, t0, t1; unpack8(*(const u32x4*)(rowp + C_GTB + bj * HALF), g0, g1); unpack8(*(const u32x4*)(rowp + C_YM + bj * HALF), t0, t1);
                    *(u32x4*)(rowp + C_YM + bj * HALF) = pack8(t0 + acc[ai][bj][m][0] * g0, t1 + acc[ai][bj][m][1] * g1); } }
    }
};

template <class Epi, class Sched, bool ALIGN_EPI = false, bool SP2 = false>
__device__ __forceinline__ void gemm_phase(PG8_LAS unsigned char* lds, const Gemm g, const Sched& S, const Epi& E) {
    int tid_ = threadIdx.x; asm volatile("" : "+v"(tid_)); const int tid = tid_, wid = __builtin_amdgcn_readfirstlane(tid >> 6), lane = tid & 63, wr = wid >> 2, wc = wid & 3, fr = lane & 15, fq = lane >> 4;
    const int K = g.K, nt = K / BK;
    unsigned voffA[2], voffB[2];
#pragma unroll
    for (int i = 0; i < 2; ++i) { int R, C; stage_rc(tid * 16 + i * 8192, R, C); const int Rb = Epi::PERM ? ((R & ~31) + perm32(R & 31)) : R;
        voffA[i] = (unsigned)(R * g.lda + C) * 2u; voffB[i] = (unsigned)(Rb * K + C) * 2u; }
    const size_t kstep = (size_t)(BK * 2);
    const size_t hstep = (size_t)HALF * K * 2;
    const size_t tstep = 2 * hstep; const size_t hstepA = (size_t)HALF * g.lda * 2, tstepA = 2 * hstepA;
    const unsigned ldsw = (unsigned)wid * 1024u;
    const int aoff = lds_byte(wr * 64 + fr, fq * 8), boff = lds_byte(wc * 32 + fr, fq * 8);
#define PG8_SA(b, h) (((b) * 2 + (h)) * HTB)
#define PG8_SB(b, h) ((4 + (b) * 2 + (h)) * HTB)
#define PG8_STAGE(bufoff, gbase, voff) do { _Pragma("unroll") for (int _i = 0; _i < 2; ++_i) \
        __builtin_amdgcn_global_load_lds((const unsigned*)((const char*)(gbase) + (voff)[_i]), (PG8_LAS unsigned*)(lds + (bufoff) + ldsw + _i * 8192), 16, 0, 0); } while (0)
#define PG8_LDA(dst, b, h) do { _Pragma("unroll") for (int m = 0; m < 4; ++m) _Pragma("unroll") for (int k = 0; k < 2; ++k) dst[m][k] = *(const PG8_LAS bf16x8*)(lds + PG8_SA(b, h) + aoff + m * 2048 + k * 1024); } while (0)
#define PG8_LDB(dst, b, h) do { _Pragma("unroll") for (int n = 0; n < 2; ++n) _Pragma("unroll") for (int k = 0; k < 2; ++k) dst[n][k] = *(const PG8_LAS bf16x8*)(lds + PG8_SB(b, h) + boff + n * 2048 + k * 1024); } while (0)
#define PG8_MMA(ai, bj, At, Bt) do { __builtin_amdgcn_s_setprio(1); _Pragma("unroll") for (int m = 0; m < 4; ++m) _Pragma("unroll") for (int n = 0; n < 2; ++n) _Pragma("unroll") for (int k = 0; k < 2; ++k) \
        acc[ai][bj][m][n] = __builtin_amdgcn_mfma_f32_16x16x32_bf16(Bt[n][k], At[m][k], acc[ai][bj][m][n], 0, 0, 0); __builtin_amdgcn_s_setprio(0); } while (0)
#define PG8_WAIT_V(n) asm volatile("s_waitcnt vmcnt(" #n ")" ::: "memory")
#define PG8_WAIT_L(n) asm volatile("s_waitcnt lgkmcnt(" #n ")" ::: "memory")
#define PG8_BAR __builtin_amdgcn_s_barrier()
#define PG8_SCHED __builtin_amdgcn_sched_barrier(0)
    Unit cur, nxt; int ui = 0;
    if (!S.next(0, cur)) return;
    f32x4 acc[2][2][4][2];
#pragma unroll
    for (int a = 0; a < 2; ++a)
#pragma unroll
        for (int b = 0; b < 2; ++b)
#pragma unroll
            for (int m = 0; m < 4; ++m)
#pragma unroll
                for (int n = 0; n < 2; ++n) acc[a][b][m][n] = (f32x4){0.f, 0.f, 0.f, 0.f};
    bf16x8 At[4][2], B0[2][2], B1[2][2];
    const char* cA = (const char*)g.A + (size_t)cur.pm * tstepA; const char* cB = (const char*)g.Bt + (size_t)cur.pn * tstep;
    S.a_ready(cur);
    if constexpr (SP2) {
        PG8_STAGE(PG8_SB(0, 0), cB, voffB); PG8_STAGE(PG8_SB(0, 1), cB + hstep, voffB); PG8_STAGE(PG8_SA(0, 0), cA, voffA); PG8_STAGE(PG8_SA(0, 1), cA + hstepA, voffA);
        if (wr == 1) PG8_BAR;
        PG8_WAIT_V(2); PG8_BAR;
        PG8_STAGE(PG8_SB(1, 0), cB + kstep, voffB); PG8_STAGE(PG8_SA(1, 0), cA + kstep, voffA); PG8_STAGE(PG8_SB(1, 1), cB + hstep + kstep, voffB);
        PG8_WAIT_V(6); PG8_BAR;
    } else {
        PG8_STAGE(PG8_SB(0, 0), cB, voffB); PG8_STAGE(PG8_SA(0, 0), cA, voffA); PG8_STAGE(PG8_SB(0, 1), cB + hstep, voffB); PG8_STAGE(PG8_SA(0, 1), cA + hstepA, voffA);
        if (wr == 1) PG8_BAR;
        PG8_WAIT_V(4); PG8_BAR;
        PG8_STAGE(PG8_SB(1, 0), cB + kstep, voffB); PG8_STAGE(PG8_SA(1, 0), cA + kstep, voffA); PG8_STAGE(PG8_SB(1, 1), cB + hstep + kstep, voffB);
        PG8_WAIT_V(6); PG8_BAR;
    }
    for (;;) {
        const bool has_next = S.next(ui + 1, nxt);
        const char* nA = has_next ? (const char*)g.A + (size_t)nxt.pm * tstepA : cA; const char* nB = has_next ? (const char*)g.Bt + (size_t)nxt.pn * tstep : cB;
        for (int t = 0; t < nt; t += 2) {
            const bool last = (t == nt - 2);
            const char* a1 = cA + (size_t)(t + 1) * kstep;
            const char* a2 = last ? nA : cA + (size_t)(t + 2) * kstep; const char* b2 = last ? nB : cB + (size_t)(t + 2) * kstep;
            const char* a3 = a2 + kstep; const char* b3 = b2 + kstep;
            if (last && has_next) S.a_ready(nxt);
            if constexpr (SP2) {
            PG8_LDB(B0, 0, 0); PG8_LDB(B1, 0, 1); PG8_SCHED; PG8_LDA(At, 0, 0); PG8_STAGE(PG8_SA(1, 1), a1 + hstepA, voffA);
            PG8_WAIT_V(8); PG8_WAIT_L(0); PG8_BAR; PG8_MMA(0, 0, At, B0); PG8_MMA(0, 1, At, B1); PG8_BAR; PG8_SCHED;
            PG8_LDA(At, 0, 1); PG8_STAGE(PG8_SB(0, 0), b2, voffB); PG8_STAGE(PG8_SB(0, 1), b2 + hstep, voffB); PG8_STAGE(PG8_SA(0, 0), a2, voffA);
            PG8_WAIT_V(8); PG8_WAIT_L(0); PG8_BAR; PG8_MMA(1, 0, At, B0); PG8_MMA(1, 1, At, B1); PG8_BAR; PG8_SCHED;
            PG8_LDB(B0, 1, 0); PG8_LDB(B1, 1, 1); PG8_SCHED; PG8_LDA(At, 1, 0); PG8_STAGE(PG8_SA(0, 1), a2 + hstepA, voffA);
            PG8_WAIT_V(8); PG8_WAIT_L(0); PG8_BAR; PG8_MMA(0, 0, At, B0); PG8_MMA(0, 1, At, B1); PG8_BAR; PG8_SCHED;
            PG8_LDA(At, 1, 1); PG8_STAGE(PG8_SB(1, 0), b3, voffB); PG8_STAGE(PG8_SB(1, 1), b3 + hstep, voffB); PG8_STAGE(PG8_SA(1, 0), a3, voffA);
            PG8_WAIT_V(8); PG8_WAIT_L(0); PG8_BAR; PG8_MMA(1, 0, At, B0); PG8_MMA(1, 1, At, B1); PG8_BAR; PG8_SCHED;
            } else {
            PG8_LDB(B0, 0, 0); PG8_SCHED; PG8_LDA(At, 0, 0); PG8_STAGE(PG8_SA(1, 1), a1 + hstepA, voffA);
            PG8_WAIT_L(8); PG8_BAR; PG8_WAIT_L(0); PG8_MMA(0, 0, At, B0); PG8_BAR; PG8_SCHED;
            PG8_LDB(B1, 0, 1); PG8_STAGE(PG8_SB(0, 0), b2, voffB);
            PG8_BAR; PG8_WAIT_L(0); PG8_MMA(0, 1, At, B1); PG8_BAR;
            PG8_LDA(At, 0, 1); PG8_STAGE(PG8_SA(0, 0), a2, voffA);
            PG8_BAR; PG8_WAIT_L(0); PG8_MMA(1, 0, At, B0); PG8_BAR; PG8_SCHED;
            PG8_STAGE(PG8_SB(0, 1), b2 + hstep, voffB);
            PG8_WAIT_V(6); PG8_BAR; PG8_MMA(1, 1, At, B1); PG8_BAR;
            PG8_LDB(B0, 1, 0); PG8_SCHED; PG8_LDA(At, 1, 0); PG8_STAGE(PG8_SA(0, 1), a2 + hstepA, voffA);
            PG8_WAIT_L(8); PG8_BAR; PG8_WAIT_L(0); PG8_MMA(0, 0, At, B0); PG8_BAR; PG8_SCHED;
            PG8_LDB(B1, 1, 1); PG8_STAGE(PG8_SB(1, 0), b3, voffB);
            PG8_BAR; PG8_WAIT_L(0); PG8_MMA(0, 1, At, B1); PG8_BAR;
            PG8_LDA(At, 1, 1); PG8_STAGE(PG8_SA(1, 0), a3, voffA);
            PG8_BAR; PG8_WAIT_L(0); PG8_MMA(1, 0, At, B0); PG8_BAR; PG8_SCHED;
            PG8_STAGE(PG8_SB(1, 1), b3 + hstep, voffB);
            PG8_WAIT_V(6); PG8_BAR; PG8_MMA(1, 1, At, B1); PG8_BAR;
            }
        }
        if constexpr (ALIGN_EPI) { if (wr == 0) PG8_BAR; }
        if constexpr (!Epi::AFTER_DRAIN) { E(acc, cur, wr, wc, fr, fq); S.done(cur); }
        if (!has_next) break;
#pragma unroll
        for (int a = 0; a < 2; ++a)
#pragma unroll
            for (int b = 0; b < 2; ++b)
#pragma unroll
                for (int m = 0; m < 4; ++m)
#pragma unroll
                    for (int n = 0; n < 2; ++n) acc[a][b][m][n] = (f32x4){0.f, 0.f, 0.f, 0.f};
        cur = nxt; cA = nA; cB = nB; ++ui;
        if constexpr (ALIGN_EPI) { if (wr == 1) PG8_BAR; }
    }
    PG8_WAIT_V(0);
    if constexpr (!ALIGN_EPI) { if (wr == 0) PG8_BAR; }
    PG8_BAR;
    if constexpr (Epi::AFTER_DRAIN) { E.fused(acc, cur, wr, wc, fr, fq, lds, wid, lane); S.done(cur); }
#undef PG8_SA
#undef PG8_SB
#undef PG8_STAGE
#undef PG8_LDA
#undef PG8_LDB
#undef PG8_MMA
#undef PG8_WAIT_V
#undef PG8_WAIT_L
#undef PG8_BAR
#undef PG8_SCHED
}
}

typedef unsigned short bf16_t;
typedef short bf16x8 __attribute__((ext_vector_type(8)));
typedef short s16x4 __attribute__((ext_vector_type(4)));
typedef float f32x4 __attribute__((ext_vector_type(4)));
typedef float f32x16 __attribute__((ext_vector_type(16)));
typedef unsigned u32x4 __attribute__((ext_vector_type(4)));
typedef unsigned u32x2 __attribute__((ext_vector_type(2)));
using pg8::bf2f; using pg8::cvt_pk_bf16; using pg8::fsigmoid; using pg8::logsigmoidf;

constexpr int NTHREADS = 512, NWAVES = 8;
constexpr int LDS_MAIN = 131072;
constexpr int LDS_BYTES = LDS_MAIN + 256;

constexpr size_t SZ_WGU = (size_t)NGU * DM * 2, SZ_WD = (size_t)DM * DFF * 2, SZ_WIN = (size_t)NINP * DM * 2, SZ_WO5 = (size_t)DM * 512 * 2, SZ_WOUT = (size_t)DM * DM * 2;
constexpr size_t WS_WGU1 = 0, WS_WD1 = WS_WGU1 + SZ_WGU, WS_WIN = WS_WD1 + SZ_WD, WS_WFO = WS_WIN + SZ_WIN, WS_WGO = WS_WFO + SZ_WO5, WS_WOUT = WS_WGO + SZ_WO5,
                 WS_WGU2 = WS_WOUT + SZ_WOUT, WS_WD2 = WS_WGU2 + SZ_WGU, WS_HM = WS_WD2 + SZ_WD;
constexpr size_t WS_LF = WS_HM + (size_t)NB * BLK * DM * 4;
constexpr size_t WS_GA = WS_LF + (size_t)MR * 8 * 4;
constexpr size_t WS_CUM = WS_GA + (size_t)MR * 16 * 4;
constexpr size_t WS_DEC = WS_CUM + (size_t)16 * LP * 4;
constexpr size_t WS_KMAX = WS_DEC + (size_t)8 * NCH * 64 * 4;
constexpr size_t WS_BAR = WS_KMAX + 256;
constexpr size_t WS_R1 = WS_BAR + 16384;
constexpr size_t WS_R2 = WS_R1 + (size_t)MR * DM * 2;
constexpr size_t WS_END = WS_R2 + (size_t)MR * PP * 2;
static_assert(WS_END <= (size_t)256 * 1024 * 1024, "workspace map exceeds 256 MiB");
static_assert((size_t)8 * NCH * 128 * 64 * 4 <= (size_t)MR * DM * 2, "GLA states must fit region R1");

struct Args {
    const float* x; const float* meta; const float* w_in; const float* w_alpha_up; const float* b_alpha; const float* b_f; const float* g_gla_out;
    const float* w_fox_o; const float* w_gla_o; const float* w_out; const float* w_gu1; const float* w_d1; const float* w_gu2; const float* w_d2;
    const float* g_pre1; const float* g_post1; const float* g_prem; const float* g_postm; const float* g_pre2; const float* g_post2;
    float* out; unsigned char* ws;
};

__device__ __forceinline__ float* hrow(float* out, float* hm, int r) {
    const int b = r >= LP ? 1 : 0, p = r - b * LP;
    return p < BLK ? hm + (size_t)(b * BLK + p) * DM : out + ((size_t)b * SEQ + (p - BLK)) * DM;
}
__device__ __forceinline__ int otid() { int t = threadIdx.x; asm volatile("" : "+v"(t)); return t; }
__device__ __forceinline__ float wave_sum(float v) {
#pragma unroll
    for (int o = 32; o > 0; o >>= 1) v += __shfl_xor(v, o);
    return v;
}

__device__ __forceinline__ int src_col(int kind, int n) {
    if (kind == 0) return n;
    if (kind == 1) { const int t = n >> 8, w = n & 255; return (w >> 7) * DFF + 128 * t + (w & 127); }
    if (n < 1536) return n;
    if (n < 2560) return n + 8;
    if (n < 5120) return n + 24;
    if (n < 5128) return n - 5120 + 1536;
    if (n < 5144) return n - 5128 + 2568;
    return -1;
}
constexpr int CT0 = 1408, CT1 = CT0 + 704, CT2 = CT1 + 1344, CT3 = CT2 + 128, CT4 = CT3 + 128, CT5 = CT4 + 256, CT6 = CT5 + 1408, CT7 = CT6 + 704;
__device__ __forceinline__ void conv_setup(const Args& ar, int layer, int t, int tid, const float*& lp, bool& ok, bf16_t*& sp) {
    unsigned char* ws = ar.ws;
    const float* src; bf16_t* dst; int K, ldsrc, kind, tt;
    if (t < CT0)      { src = ar.w_gu1 + (size_t)layer * DM * NGU;   dst = (bf16_t*)(ws + WS_WGU1); K = DM;  ldsrc = NGU; kind = 1; tt = t; }
    else if (t < CT1) { src = ar.w_d1 + (size_t)layer * DFF * DM;    dst = (bf16_t*)(ws + WS_WD1);  K = DFF; ldsrc = DM;  kind = 0; tt = t - CT0; }
    else if (t < CT2) { src = ar.w_in + (size_t)layer * DM * NIN;    dst = (bf16_t*)(ws + WS_WIN);  K = DM;  ldsrc = NIN; kind = 2; tt = t - CT1; }
    else if (t < CT3) { src = ar.w_fox_o + (size_t)layer * 512 * DM; dst = (bf16_t*)(ws + WS_WFO);  K = 512; ldsrc = DM;  kind = 0; tt = t - CT2; }
    else if (t < CT4) { src = ar.w_gla_o + (size_t)layer * 512 * DM; dst = (bf16_t*)(ws + WS_WGO);  K = 512; ldsrc = DM;  kind = 0; tt = t - CT3; }
    else if (t < CT5) { src = ar.w_out + (size_t)layer * DM * DM;    dst = (bf16_t*)(ws + WS_WOUT); K = DM;  ldsrc = DM;  kind = 0; tt = t - CT4; }
    else if (t < CT6) { src = ar.w_gu2 + (size_t)layer * DM * NGU;   dst = (bf16_t*)(ws + WS_WGU2); K = DM;  ldsrc = NGU; kind = 1; tt = t - CT5; }
    else              { src = ar.w_d2 + (size_t)layer * DFF * DM;    dst = (bf16_t*)(ws + WS_WD2);  K = DFF; ldsrc = DM;  kind = 0; tt = t - CT6; }
    const int nk = K >> 6, n0 = (tt / nk) << 6, k0 = (tt % nk) << 6;
    const int sc = src_col(kind, n0 + 8 * (tid & 7));
    ok = sc >= 0; lp = src + (size_t)(k0 + (tid >> 3)) * ldsrc + (ok ? sc : 0);
    sp = dst + (size_t)(n0 + (tid >> 3)) * K + k0 + 8 * (tid & 7);
}
__device__ __forceinline__ void convert_phase(const Args& ar, int layer, unsigned char* lds) {
    const int tid = otid(); const int kl = tid >> 3, c8 = tid & 7;
    const float* lp; bool ok; bf16_t* sp; f32x4 v0 = {0.f, 0.f, 0.f, 0.f}, v1 = v0;
    int t = blockIdx.x, buf = 0;
    if (t < CT7) { conv_setup(ar, layer, t, tid, lp, ok, sp); if (ok) { v0 = *(const f32x4*)lp; v1 = *(const f32x4*)(lp + 4); } else { v0 = (f32x4){0.f, 0.f, 0.f, 0.f}; v1 = v0; } }
#pragma unroll 1
    for (; t < CT7; t += gridDim.x) {
        bf16_t* T = (bf16_t*)(lds + buf * 9216);
        { const unsigned a = cvt_pk_bf16(v0[0], v0[1]), b = cvt_pk_bf16(v0[2], v0[3]), cc = cvt_pk_bf16(v1[0], v1[1]), d = cvt_pk_bf16(v1[2], v1[3]);
          bf16_t* q = T + (8 * c8) * 72 + (kl ^ (8 * c8));
          q[0] = (bf16_t)a; q[72] = (bf16_t)(a >> 16); q[144] = (bf16_t)b; q[216] = (bf16_t)(b >> 16); q[288] = (bf16_t)cc; q[360] = (bf16_t)(cc >> 16); q[432] = (bf16_t)d; q[504] = (bf16_t)(d >> 16); }
        __syncthreads();
        bf16_t* spc = sp;
        const int tn = t + gridDim.x;
        if (tn < CT7) { conv_setup(ar, layer, tn, tid, lp, ok, sp); if (ok) { v0 = *(const f32x4*)lp; v1 = *(const f32x4*)(lp + 4); } else { v0 = (f32x4){0.f, 0.f, 0.f, 0.f}; v1 = v0; } }
        *(u32x4*)spc = *(const u32x4*)(T + kl * 72 + ((8 * c8) ^ (8 * ((kl >> 3) & 7))));
        buf ^= 1;
    }
    __syncthreads();
}

template <int MODE>
__device__ __forceinline__ void norm_phase(const Args& ar, const bf16_t* y, bf16_t* a, float coef, const float* gpost, const float* gpre, const bool dry = false) {
    float* hm = (float*)(ar.ws + WS_HM);
    const int tid = otid(); const int lane = tid & 63, wv = tid >> 6;
    const int stride = gridDim.x * NWAVES;
    for (int r0 = blockIdx.x * NWAVES + wv; r0 < MR; r0 += 2 * stride) {
        const bool has1 = r0 + stride < MR; const int rr[2] = {r0, has1 ? r0 + stride : r0};
        f32x4 h[2][4], v[2][4]; float* hp[2];
#pragma unroll
        for (int q = 0; q < 2; ++q) { const int r = rr[q]; hp[q] = hrow(ar.out, hm, r); const int b = r >= LP ? 1 : 0, p = r - b * LP;
            if (MODE == 0) {
#pragma unroll
                for (int i = 0; i < 4; ++i) { const int c = 256 * i + 4 * lane;
                    if (p < NPAD) h[q][i] = (f32x4){0.f, 0.f, 0.f, 0.f};
                    else if (p < BLK) h[q][i] = *(const f32x4*)(ar.meta + (size_t)(p - NPAD) * DM + c);
                    else h[q][i] = *(const f32x4*)(ar.x + ((size_t)b * SEQ + (p - BLK)) * DM + c); }
            } else {
#pragma unroll
                for (int i = 0; i < 4; ++i) { const int c = 256 * i + 4 * lane; const u32x2 w = __builtin_nontemporal_load((const u32x2*)(y + (size_t)r * DM + c));
                    v[q][i][0] = __uint_as_float(w.x << 16); v[q][i][1] = __uint_as_float(w.x & 0xffff0000u); v[q][i][2] = __uint_as_float(w.y << 16); v[q][i][3] = __uint_as_float(w.y & 0xffff0000u);
                    h[q][i] = __builtin_nontemporal_load((const f32x4*)(hp[q] + c)); }
            } }
#pragma unroll
        for (int q = 0; q < 2; ++q) { if (q == 1 && !has1) break; const int r = rr[q];
            if (MODE == 1) { float ss = 0.f;
#pragma unroll
                for (int i = 0; i < 4; ++i) ss += v[q][i][0] * v[q][i][0] + v[q][i][1] * v[q][i][1] + v[q][i][2] * v[q][i][2] + v[q][i][3] * v[q][i][3];
                ss = wave_sum(ss); const float rs = coef * rsqrtf(ss * (1.0f / DM) + RMS_EPS);
#pragma unroll
                for (int i = 0; i < 4; ++i) { const int c = 256 * i + 4 * lane; const f32x4 g = *(const f32x4*)(gpost + c); h[q][i] = h[q][i] + v[q][i] * g * rs; } }
#pragma unroll
            for (int i = 0; i < 4; ++i) if (!dry) __builtin_nontemporal_store(h[q][i], (f32x4*)(hp[q] + 256 * i + 4 * lane));
            if (gpre) { float ss = 0.f;
#pragma unroll
                for (int i = 0; i < 4; ++i) ss += h[q][i][0] * h[q][i][0] + h[q][i][1] * h[q][i][1] + h[q][i][2] * h[q][i][2] + h[q][i][3] * h[q][i][3];
                ss = wave_sum(ss); const float rs = rsqrtf(ss * (1.0f / DM) + RMS_EPS);
#pragma unroll
                for (int i = 0; i < 4; ++i) { const int c = 256 * i + 4 * lane; const f32x4 g = *(const f32x4*)(gpre + c); const f32x4 o = h[q][i] * g * rs;
                    u32x2 w; w.x = cvt_pk_bf16(o[0], o[1]); w.y = cvt_pk_bf16(o[2], o[3]); if (!dry) *(u32x2*)(a + (size_t)r * DM + c) = w; } }
        }
    }
}

__device__ __forceinline__ void cumsum_phase(const float* LF, float* CUM, unsigned char* lds) {
    if (blockIdx.x >= 16) return;
    const int tid = otid(), lane = tid & 63, wv = tid >> 6, seq = blockIdx.x, b = seq >> 3, hh = seq & 7, p0 = 17 * tid;
    float* wt = (float*)lds;
    float v[17]; float s = 0.f;
#pragma unroll
    for (int i = 0; i < 17; ++i) { const int p = p0 + i; const float x = p < LP ? LF[(size_t)(b * LP + p) * 8 + hh] : 0.f; s += x; v[i] = s; }
    float sc = s;
#pragma unroll
    for (int o = 1; o < 64; o <<= 1) { const float t = __shfl_up(sc, o); if (lane >= o) sc += t; }
    if (lane == 63) wt[wv] = sc;
    __syncthreads();
    float off = sc - s;
#pragma unroll
    for (int w2 = 0; w2 < 8; ++w2) off += (w2 < wv) ? wt[w2] : 0.f;
#pragma unroll
    for (int i = 0; i < 17; ++i) { const int p = p0 + i; if (p < LP) CUM[(size_t)seq * LP + p] = v[i] + off; }
    __syncthreads();
}

constexpr float PRUNE_T = 40.0f;
__device__ __forceinline__ void kmax_phase(const bf16_t* P, unsigned* KMAX, unsigned char* lds) {
    const int tid = otid(), lane = tid & 63, wv = tid >> 6; float mx0 = 0.f, mx1 = 0.f;
    const int stride = gridDim.x * NWAVES;
    for (int rb = blockIdx.x * NWAVES + wv; rb < MR; rb += 9 * stride) {
        u32x4 kv9[9];
#pragma unroll
        for (int q = 0; q < 9; ++q) { const int r = rb + q * stride; kv9[q] = r < MR ? *(const u32x4*)(P + (size_t)r * PP + C_FK + 8 * lane) : (u32x4){0u, 0u, 0u, 0u}; }
#pragma unroll
        for (int q = 0; q < 9; ++q) { const int r = rb + q * stride; const u32x4 kv = kv9[q];
            const float a0 = __uint_as_float(kv.x << 16), a1 = __uint_as_float(kv.x & 0xffff0000u), a2 = __uint_as_float(kv.y << 16), a3 = __uint_as_float(kv.y & 0xffff0000u),
                        a4 = __uint_as_float(kv.z << 16), a5 = __uint_as_float(kv.z & 0xffff0000u), a6 = __uint_as_float(kv.w << 16), a7 = __uint_as_float(kv.w & 0xffff0000u);
            float ss = a0 * a0 + a1 * a1 + a2 * a2 + a3 * a3 + a4 * a4 + a5 * a5 + a6 * a6 + a7 * a7;
            ss += __shfl_xor(ss, 1); ss += __shfl_xor(ss, 2); ss += __shfl_xor(ss, 4);
            if (r >= LP) mx1 = fmaxf(mx1, ss); else mx0 = fmaxf(mx0, ss); }
    }
    float* red = (float*)lds;
    if ((lane & 7) == 0) { red[(lane >> 3) * 8 + wv] = mx0; red[64 + (lane >> 3) * 8 + wv] = mx1; }
    __syncthreads();
    if (tid < 16) { float m = 0.f;
#pragma unroll
        for (int i = 0; i < 8; ++i) m = fmaxf(m, red[tid * 8 + i]);
        atomicMax(KMAX + tid, __float_as_uint(m)); }
    __syncthreads();
}
__device__ __forceinline__ void attn_unit(int b, int hh, int qb, bf16_t* P, const float* CUM, const unsigned* KMAX, unsigned char* lds, const bool dry) {
    const int tid = otid(), lane = tid & 63, w = tid >> 6, g = w >> 2, wq = w & 3, l31 = lane & 31, hi = lane >> 5, gt = tid & 255;
    const size_t rowbase = (size_t)b * LP;
    const int qp = BLK * qb + 32 * wq + l31;
    const float* cum = CUM + (size_t)(b * 8 + hh) * LP;
    unsigned char* gl = lds + g * 40960;
    float* comb = (float*)(lds + 81920);
    float* misc = (float*)(lds + 116736);
    const bool active = (BLK * qb + 32 * wq + 31) >= NPAD;
    bf16x8 qf[4];
    { const bf16_t* qptr = P + (rowbase + qp) * PP + C_FQ + 64 * hh + 8 * hi;
#pragma unroll
      for (int s = 0; s < 4; ++s) qf[s] = *(const bf16x8*)(qptr + 16 * s); }
    const float ct = cum[qp] * LOG2E;
    const int jhi = 4 * qb + 3;
    const int srow = gt >> 3, sc8 = gt & 7;
    u32x4 kreg[2], vreg[2]; float csreg[2];
    const int vrow = gt & 31, vc8 = gt >> 5;
#define ATT_LOAD2(jj) do { _Pragma("unroll") for (int s2 = 0; s2 < 2; ++s2) { const int j_ = max((jj) - s2, 0); \
        const bf16_t* kp = P + (rowbase + 32 * j_ + srow) * PP + 64 * hh + 8 * sc8; kreg[s2] = *(const u32x4*)(kp + C_FK); vreg[s2] = *(const u32x4*)(P + (rowbase + 32 * j_ + vrow) * PP + C_FV + 64 * hh + 8 * vc8); \
        csreg[s2] = cum[32 * j_ + (gt & 31)]; } } while (0)
    ATT_LOAD2(jhi - 2 * g);
    const unsigned kmax_bits = KMAX[b * 8 + hh];
    const int jcand = 3 + tid; const float cum_blk = cum[BLK * qb], cum_cand = jcand < 4 * qb ? cum[32 * jcand + 31] : 0.f;
    { float qn = 0.f;
#pragma unroll
      for (int s = 0; s < 4; ++s)
#pragma unroll
          for (int j = 0; j < 8; ++j) { const float v = bf2f((unsigned short)qf[s][j]); qn += v * v; }
      qn += __shfl_xor(qn, 32);
#pragma unroll
      for (int o = 16; o > 0; o >>= 1) qn = fmaxf(qn, __shfl_xor(qn, o));
      if (lane == 0) misc[w] = qn;
      if (tid == 0) ((int*)misc)[8] = 3; }
    __syncthreads();
    { float qn = misc[0];
#pragma unroll
      for (int i = 1; i < 8; ++i) qn = fmaxf(qn, misc[i]);
      const float kmax = sqrtf(__uint_as_float(kmax_bits));
      const float thr = -(2.02f * sqrtf(qn) * kmax + PRUNE_T) * (1.0f / LOG2E);
      if (jcand < 4 * qb) { if (cum_blk - cum_cand < thr) atomicMax((int*)misc + 8, jcand + 1); } }
    __syncthreads();
    const int jlo = ((const int*)misc)[8];
    const int nchunk = (jhi - jlo + 2) >> 1, niter = (nchunk + 1) >> 1;
    float m = -INFINITY, lsum = 0.f; f32x16 o0, o1;
#pragma unroll
    for (int r = 0; r < 16; ++r) { o0[r] = 0.f; o1[r] = 0.f; }
#define ATT_STORE2(jj, bufsel) do { _Pragma("unroll") for (int s2 = 0; s2 < 2; ++s2) { const int j_ = (jj) - s2; if (j_ >= jlo) { unsigned char* bb = gl + (bufsel) * 20480 + s2 * 10240; bf16_t* Kl_ = (bf16_t*)bb; bf16_t* vt = (bf16_t*)(bb + 4608) + (8 * vc8) * 40 + vrow; \
        *(u32x4*)(Kl_ + srow * 72 + 8 * sc8) = kreg[s2]; \
        vt[0] = (bf16_t)vreg[s2].x; vt[40] = (bf16_t)(vreg[s2].x >> 16); vt[80] = (bf16_t)vreg[s2].y; vt[120] = (bf16_t)(vreg[s2].y >> 16); \
        vt[160] = (bf16_t)vreg[s2].z; vt[200] = (bf16_t)(vreg[s2].z >> 16); vt[240] = (bf16_t)vreg[s2].w; vt[280] = (bf16_t)(vreg[s2].w >> 16); \
        if (gt < 32) ((float*)(bb + 9728))[gt] = (32 * j_ + gt >= NPAD) ? csreg[s2] * LOG2E : INFINITY; } } } while (0)
    ATT_STORE2(jhi - 2 * g, 0); ATT_LOAD2(jhi - 2 * g - 4);
    __syncthreads();
    for (int it = 0; it < niter; ++it) {
        const int ja = jhi - 2 * g - 4 * it;
        ATT_STORE2(ja - 4, (it + 1) & 1);
        ATT_LOAD2(ja - 8);
#pragma unroll
        for (int s2 = 0; s2 < 2; ++s2) { const int j = ja - s2;
        if (j >= jlo && active && j <= 4 * qb + wq) {
            const unsigned char* bb = gl + (it & 1) * 20480 + s2 * 10240; const bf16_t* Kl = (const bf16_t*)bb; const bf16_t* Vt = (const bf16_t*)(bb + 4608); const float* csl = (const float*)(bb + 9728);
            f32x16 sacc;
#pragma unroll
            for (int g4 = 0; g4 < 4; ++g4) { const f32x4 c4 = *(const f32x4*)(csl + 8 * g4 + 4 * hi);
#pragma unroll
                for (int i = 0; i < 4; ++i) sacc[4 * g4 + i] = ct - c4[i]; }
#pragma unroll
            for (int s = 0; s < 4; ++s) { const bf16x8 kf = *(const bf16x8*)(Kl + l31 * 72 + 16 * s + 8 * hi); sacc = __builtin_amdgcn_mfma_f32_32x32x16_bf16(kf, qf[s], sacc, 0, 0, 0); }
            if (j == 4 * qb + wq) {
                asm volatile("" ::: "memory");
#pragma unroll
                for (int r = 0; r < 16; ++r) { const int kpos = 32 * j + 8 * (r >> 2) + 4 * hi + (r & 3); if (kpos > qp) sacc[r] = -INFINITY; } }
            float tmax = -INFINITY;
#pragma unroll
            for (int r = 0; r < 16; ++r) tmax = fmaxf(tmax, sacc[r]);
            tmax = fmaxf(tmax, __shfl_xor(tmax, 32));
            const float mnew = fmaxf(m, tmax), muse = mnew == -INFINITY ? 0.f : mnew;
            const float alpha = __builtin_amdgcn_exp2f(m - muse);
            m = mnew; lsum *= alpha;
#pragma unroll
            for (int r = 0; r < 16; ++r) { o0[r] *= alpha; o1[r] *= alpha; }
            float ps = 0.f;
#pragma unroll
            for (int r = 0; r < 16; ++r) { const float pv = __builtin_amdgcn_exp2f(sacc[r] - muse); sacc[r] = pv; ps += pv; }
            lsum += ps;
#pragma unroll
            for (int s = 0; s < 2; ++s) {
                u32x4 pw; pw.x = cvt_pk_bf16(sacc[8 * s + 0], sacc[8 * s + 1]); pw.y = cvt_pk_bf16(sacc[8 * s + 2], sacc[8 * s + 3]); pw.z = cvt_pk_bf16(sacc[8 * s + 4], sacc[8 * s + 5]); pw.w = cvt_pk_bf16(sacc[8 * s + 6], sacc[8 * s + 7]);
                const bf16x8 pf = __builtin_bit_cast(bf16x8, pw);
                { const bf16_t* vp = Vt + l31 * 40 + 16 * s + 4 * hi; const u32x2 lo = *(const u32x2*)vp, hi2 = *(const u32x2*)(vp + 8); u32x4 vv; vv.x = lo.x; vv.y = lo.y; vv.z = hi2.x; vv.w = hi2.y;
                  o0 = __builtin_amdgcn_mfma_f32_32x32x16_bf16(__builtin_bit_cast(bf16x8, vv), pf, o0, 0, 0, 0); }
                { const bf16_t* vp = Vt + (32 + l31) * 40 + 16 * s + 4 * hi; const u32x2 lo = *(const u32x2*)vp, hi2 = *(const u32x2*)(vp + 8); u32x4 vv; vv.x = lo.x; vv.y = lo.y; vv.z = hi2.x; vv.w = hi2.y;
                  o1 = __builtin_amdgcn_mfma_f32_32x32x16_bf16(__builtin_bit_cast(bf16x8, vv), pf, o1, 0, 0, 0); }
            }
        }
        }
        __syncthreads();
    }
#undef ATT_LOAD2
#undef ATT_STORE2
    lsum += __shfl_xor(lsum, 32);
    float* cb = comb + (size_t)(wq * 64 + lane) * 34;
    if (g == 1) { cb[0] = m; cb[1] = lsum;
#pragma unroll
        for (int r = 0; r < 16; ++r) { cb[2 + r] = o0[r]; cb[18 + r] = o1[r]; } }
    __syncthreads();
    if (g == 0 && qp >= NPAD && !dry) {
        const float m1 = cb[0], l1 = cb[1];
        const float mf = fmaxf(m, m1), a0 = __builtin_amdgcn_exp2f(m - mf), a1 = __builtin_amdgcn_exp2f(m1 - mf);
        const float inv = 1.0f / (lsum * a0 + l1 * a1);
        bf16_t* op = P + (rowbase + qp) * PP + C_FQ + 64 * hh + 4 * hi;
#pragma unroll
        for (int g4 = 0; g4 < 4; ++g4) {
            u32x2 w0, w1; float t0[4], t1[4];
#pragma unroll
            for (int i = 0; i < 4; ++i) { t0[i] = (o0[4 * g4 + i] * a0 + cb[2 + 4 * g4 + i] * a1) * inv; t1[i] = (o1[4 * g4 + i] * a0 + cb[18 + 4 * g4 + i] * a1) * inv; }
            w0.x = cvt_pk_bf16(t0[0], t0[1]); w0.y = cvt_pk_bf16(t0[2], t0[3]); w1.x = cvt_pk_bf16(t1[0], t1[1]); w1.y = cvt_pk_bf16(t1[2], t1[3]);
            *(u32x2*)(op + 8 * g4) = w0; *(u32x2*)(op + 32 + 8 * g4) = w1;
        }
    }
    __syncthreads();
}
__device__ __forceinline__ void attn_phase(bf16_t* P, const float* CUM, const unsigned* KMAX, unsigned char* lds, const bool dry) {
    const int c = blockIdx.x, G = gridDim.x;
    for (int rd = 0;; ++rd) {
        const int idx = (rd & 1) ? (rd + 1) * G - 1 - c : rd * G + c;
        if (rd * G >= 16 * NCH) break;
        if (idx >= 16 * NCH) continue;
        const int qb = NCH - 1 - idx / 16, bh = idx & 15;
        attn_unit(bh >> 3, bh & 7, qb, P, CUM, KMAX, lds, dry);
    }
}

constexpr int L_CB = 0, L_QT = 32768, L_KT = 51200, L_VT = 69632, L_ST = 104448, L_GAL = 122880;
static_assert(L_GAL + 8192 <= LDS_MAIN, "GLA LDS map");
__device__ __forceinline__ void gla_cb(int b, int hh, int c, const Args& ar, int layer, unsigned char* lds) {
    const int tid = otid(), k = tid & 63, seg = tid >> 6;
    float* CB = (float*)(lds + L_CB); float* SEG = (float*)(lds + L_QT); float* GAL = (float*)(lds + L_GAL);
    const float* GA = (const float*)(ar.ws + WS_GA);
    const size_t r0 = (size_t)b * LP + (size_t)BLK * c;
    *(f32x4*)(GAL + 4 * tid) = *(const f32x4*)(GA + r0 * 16 + 4 * tid);
    float wcol[16];
#pragma unroll
    for (int r = 0; r < 16; ++r) wcol[r] = ar.w_alpha_up[(size_t)layer * 16 * 256 + r * 256 + 64 * hh + k];
    const float bias = ar.b_alpha[layer * 256 + 64 * hh + k];
    __syncthreads();
    float vals[16]; float run = 0.f;
#pragma unroll
    for (int i = 0; i < 16; ++i) { const int t = 16 * seg + i; float x = bias;
#pragma unroll
        for (int r4 = 0; r4 < 4; ++r4) { const f32x4 gv = *(const f32x4*)(GAL + t * 16 + 4 * r4); x += gv[0] * wcol[4 * r4] + gv[1] * wcol[4 * r4 + 1] + gv[2] * wcol[4 * r4 + 2] + gv[3] * wcol[4 * r4 + 3]; }
        const float la = (BLK * c + t >= NPAD) ? logsigmoidf(x) * (1.0f / 16.0f) : 0.f;
        run += la; vals[i] = run; }
    SEG[seg * 64 + k] = run;
    __syncthreads();
    float off = 0.f;
#pragma unroll
    for (int s = 0; s < 8; ++s) off += (s < seg) ? SEG[s * 64 + k] : 0.f;
#pragma unroll
    for (int i = 0; i < 16; ++i) CB[(16 * seg + i) * 64 + k] = vals[i] + off;
    __syncthreads();
}
__device__ __forceinline__ void gla_load_v(u32x4 (&vr)[4], const bf16_t* P, size_t r0, int hh, int tid) {
#pragma unroll
    for (int i = 0; i < 4; ++i) { const int idx = tid + 512 * i, s = idx & 127, c16 = idx >> 7; vr[i] = *(const u32x4*)(P + (r0 + s) * PP + C_GV + 128 * hh + 8 * c16); }
}
__device__ __forceinline__ void gla_store_vt(const u32x4 (&vr)[4], unsigned char* lds, int tid) {
    bf16_t* VT = (bf16_t*)(lds + L_VT);
#pragma unroll
    for (int i = 0; i < 4; ++i) { const int idx = tid + 512 * i, s = idx & 127, c16 = idx >> 7; const u32x4 v = vr[i];
        bf16_t* vt = VT + (8 * c16) * 136 + s;
        vt[0] = (bf16_t)v.x; vt[136] = (bf16_t)(v.x >> 16); vt[272] = (bf16_t)v.y; vt[408] = (bf16_t)(v.y >> 16); vt[544] = (bf16_t)v.z; vt[680] = (bf16_t)(v.z >> 16); vt[816] = (bf16_t)v.w; vt[952] = (bf16_t)(v.w >> 16); }
}
__device__ __forceinline__ void gla_g1_unit(int b, int hh, int c, const Args& ar, int layer, unsigned char* lds) {
    const int tid = otid(), k = tid & 63, seg = tid >> 6, lane = tid & 63, w = tid >> 6, l15 = lane & 15, quad = lane >> 4;
    const bf16_t* P = (const bf16_t*)(ar.ws + WS_R2); float* STG = (float*)(ar.ws + WS_R1); float* DEC = (float*)(ar.ws + WS_DEC);
    const int unit = (b * 4 + hh) * NCH + c; const size_t r0 = (size_t)b * LP + (size_t)BLK * c;
    unsigned short kraw[16]; u32x4 vraw[4];
#pragma unroll
    for (int i = 0; i < 16; ++i) kraw[i] = P[(r0 + 16 * seg + i) * PP + C_GK + 64 * hh + k];
    gla_load_v(vraw, P, r0, hh, tid);
    gla_cb(b, hh, c, ar, layer, lds);
    const float* CB = (const float*)(lds + L_CB); bf16_t* KHT = (bf16_t*)(lds + L_KT); const bf16_t* VT = (const bf16_t*)(lds + L_VT);
    { const float cl = CB[127 * 64 + k]; unsigned pk[8];
#pragma unroll
      for (int i = 0; i < 16; i += 2) { const int t = 16 * seg + i;
          const float k0 = bf2f(kraw[i]) * __expf(cl - CB[t * 64 + k]);
          const float k1 = bf2f(kraw[i + 1]) * __expf(cl - CB[(t + 1) * 64 + k]);
          pk[i >> 1] = cvt_pk_bf16(k0, k1); }
      u32x4 w0, w1; w0.x = pk[0]; w0.y = pk[1]; w0.z = pk[2]; w0.w = pk[3]; w1.x = pk[4]; w1.y = pk[5]; w1.z = pk[6]; w1.w = pk[7];
      *(u32x4*)(KHT + k * 136 + 16 * seg) = w0; *(u32x4*)(KHT + k * 136 + 16 * seg + 8) = w1;
      if (seg == 0) DEC[unit * 64 + k] = __expf(cl); }
    gla_store_vt(vraw, lds, tid);
    __syncthreads();
#pragma unroll
    for (int kt = 0; kt < 4; ++kt) { f32x4 acc = {0.f, 0.f, 0.f, 0.f};
#pragma unroll
        for (int ks = 0; ks < 4; ++ks) { const bf16x8 af = *(const bf16x8*)(KHT + (16 * kt + l15) * 136 + 32 * ks + 8 * quad); const bf16x8 bfr = *(const bf16x8*)(VT + (16 * w + l15) * 136 + 32 * ks + 8 * quad);
            acc = __builtin_amdgcn_mfma_f32_16x16x32_bf16(af, bfr, acc, 0, 0, 0); }
        *(f32x4*)(STG + ((size_t)unit * 128 + 16 * w + l15) * 64 + 16 * kt + 4 * quad) = acc; }
    __syncthreads();
}
__device__ __forceinline__ void gla_g2_phase(const Args& ar) {
    float* STG = (float*)(ar.ws + WS_R1); const float* DEC = (const float*)(ar.ws + WS_DEC);
    const int gid = blockIdx.x * NTHREADS + otid();
    if (gid >= 8 * 8192) return;
    const int bh = gid >> 13, e = gid & 8191, k = e & 63;
    float carry = 0.f;
    float u[13], d[13], un[13], dn[13];
#pragma unroll
    for (int i = 0; i < 13; ++i) { const int unit = bh * NCH + i; u[i] = STG[(size_t)unit * 8192 + e]; d[i] = DEC[unit * 64 + k]; }
#pragma unroll 1
    for (int c0 = 0; c0 < NCH; c0 += 13) {
        if (c0 + 13 < NCH) {
#pragma unroll
            for (int i = 0; i < 13; ++i) { const int unit = bh * NCH + c0 + 13 + i; un[i] = STG[(size_t)unit * 8192 + e]; dn[i] = DEC[unit * 64 + k]; } }
#pragma unroll
        for (int i = 0; i < 13; ++i) { const int unit = bh * NCH + c0 + i; STG[(size_t)unit * 8192 + e] = carry; carry = d[i] * carry + u[i]; }
#pragma unroll
        for (int i = 0; i < 13; ++i) { u[i] = un[i]; d[i] = dn[i]; }
    }
}
__device__ __forceinline__ void gla_g3_unit(int b, int hh, int c, const Args& ar, int layer, unsigned char* lds, const bool dry) {
    const int tid = otid(), k = tid & 63, seg = tid >> 6, lane = tid & 63, w = tid >> 6, l15 = lane & 15, quad = lane >> 4;
    bf16_t* P = (bf16_t*)(ar.ws + WS_R2); const float* STG = (const float*)(ar.ws + WS_R1);
    const int unit = (b * 4 + hh) * NCH + c; const size_t r0 = (size_t)b * LP + (size_t)BLK * c;
    unsigned short qraw[16], kraw[16]; float sraw[16]; u32x4 vraw[4];
#pragma unroll
    for (int i = 0; i < 16; ++i) { const bf16_t* pp = P + (r0 + 16 * seg + i) * PP + 64 * hh + k; qraw[i] = pp[C_GQ]; kraw[i] = pp[C_GK]; }
#pragma unroll
    for (int i = 0; i < 16; ++i) sraw[i] = c == 0 ? 0.f : STG[((size_t)unit * 128 + seg + 8 * i) * 64 + k];
    gla_load_v(vraw, P, r0, hh, tid);
    u32x2 grraw[8];
    { const bf16_t* gp = P + (r0 + 16 * w + l15) * PP + C_GR + 128 * hh + 4 * quad;
#pragma unroll
      for (int vt = 0; vt < 8; ++vt) grraw[vt] = *(const u32x2*)(gp + 16 * vt); }
    gla_cb(b, hh, c, ar, layer, lds);
    const float* CB = (const float*)(lds + L_CB); bf16_t* QT = (bf16_t*)(lds + L_QT); bf16_t* KT = (bf16_t*)(lds + L_KT); const bf16_t* VT = (const bf16_t*)(lds + L_VT); bf16_t* ST = (bf16_t*)(lds + L_ST);
    const float ref = CB[63 * 64 + k];
    __syncthreads();
#pragma unroll
    for (int i = 0; i < 16; ++i) { const int t = 16 * seg + i; const float cbv = CB[t * 64 + k];
        const float qv = bf2f(qraw[i]) * __expf(cbv - ref);
        const float kv = bf2f(kraw[i]) * __expf(ref - cbv);
        QT[t * 72 + k] = (bf16_t)(cvt_pk_bf16(qv, 0.f)); KT[t * 72 + k] = (bf16_t)(cvt_pk_bf16(kv, 0.f)); }
    { const float er = __expf(ref);
#pragma unroll
      for (int i = 0; i < 16; ++i) { const int v = seg + 8 * i; ST[v * 72 + k] = (bf16_t)cvt_pk_bf16(sraw[i] * er, 0.f); } }
    gla_store_vt(vraw, lds, tid);
    __syncthreads();
    f32x4 acc[8];
#pragma unroll
    for (int vt = 0; vt < 8; ++vt) acc[vt] = (f32x4){0.f, 0.f, 0.f, 0.f};
    bf16x8 bq[2];
#pragma unroll
    for (int ks = 0; ks < 2; ++ks) bq[ks] = *(const bf16x8*)(QT + (16 * w + l15) * 72 + 32 * ks + 8 * quad);
#pragma unroll
    for (int ks = 0; ks < 2; ++ks)
#pragma unroll
        for (int vt = 0; vt < 8; ++vt) { const bf16x8 af = *(const bf16x8*)(ST + (16 * vt + l15) * 72 + 32 * ks + 8 * quad); acc[vt] = __builtin_amdgcn_mfma_f32_16x16x32_bf16(af, bq[ks], acc[vt], 0, 0, 0); }
    const int npairs = (w >> 1) + 1, tq = 16 * w + l15;
    for (int pr = 0; pr < npairs; ++pr) {
        f32x4 x0 = {0.f, 0.f, 0.f, 0.f}, x1 = x0;
#pragma unroll
        for (int ks = 0; ks < 2; ++ks) { const bf16x8 a0 = *(const bf16x8*)(KT + (32 * pr + l15) * 72 + 32 * ks + 8 * quad); const bf16x8 a1 = *(const bf16x8*)(KT + (32 * pr + 16 + l15) * 72 + 32 * ks + 8 * quad);
            x0 = __builtin_amdgcn_mfma_f32_16x16x32_bf16(a0, bq[ks], x0, 0, 0, 0); x1 = __builtin_amdgcn_mfma_f32_16x16x32_bf16(a1, bq[ks], x1, 0, 0, 0); }
#pragma unroll
        for (int j = 0; j < 4; ++j) { const int s0 = 32 * pr + 4 * quad + j; if (s0 > tq) x0[j] = 0.f; if (s0 + 16 > tq) x1[j] = 0.f; }
        u32x4 pw; pw.x = cvt_pk_bf16(x0[0], x0[1]); pw.y = cvt_pk_bf16(x0[2], x0[3]); pw.z = cvt_pk_bf16(x1[0], x1[1]); pw.w = cvt_pk_bf16(x1[2], x1[3]);
        const bf16x8 pf = __builtin_bit_cast(bf16x8, pw);
#pragma unroll
        for (int vt = 0; vt < 8; ++vt) { const bf16_t* vp = VT + (16 * vt + l15) * 136 + 32 * pr + 4 * quad; const u32x2 lo = *(const u32x2*)vp, hi2 = *(const u32x2*)(vp + 16);
            u32x4 vv; vv.x = lo.x; vv.y = lo.y; vv.z = hi2.x; vv.w = hi2.y;
            acc[vt] = __builtin_amdgcn_mfma_f32_16x16x32_bf16(__builtin_bit_cast(bf16x8, vv), pf, acc[vt], 0, 0, 0); }
    }
    float ss = 0.f;
#pragma unroll
    for (int vt = 0; vt < 8; ++vt) ss += acc[vt][0] * acc[vt][0] + acc[vt][1] * acc[vt][1] + acc[vt][2] * acc[vt][2] + acc[vt][3] * acc[vt][3];
    ss += __shfl_xor(ss, 16); ss += __shfl_xor(ss, 32);
    const float rs = rsqrtf(ss * (1.0f / 128.0f) + RMS_EPS);
    const float* gg = ar.g_gla_out + layer * 512 + 128 * hh;
    bf16_t* op = P + (r0 + tq) * PP + C_GR + 128 * hh + 4 * quad;
#pragma unroll
    for (int vt = 0; vt < 8; ++vt) { const u32x2 gr = grraw[vt]; const f32x4 g4 = *(const f32x4*)(gg + 16 * vt + 4 * quad);
        const float r0v = __uint_as_float(gr.x << 16), r1v = __uint_as_float(gr.x & 0xffff0000u), r2v = __uint_as_float(gr.y << 16), r3v = __uint_as_float(gr.y & 0xffff0000u);
        u32x2 wv; wv.x = cvt_pk_bf16(acc[vt][0] * rs * g4[0] * r0v, acc[vt][1] * rs * g4[1] * r1v); wv.y = cvt_pk_bf16(acc[vt][2] * rs * g4[2] * r2v, acc[vt][3] * rs * g4[3] * r3v);
        if (!dry) *(u32x2*)(op + 16 * vt) = wv; }
    __syncthreads();
}


constexpr int MAIN_ROWS = 64 * 256;
template <int EPI, int NS>
__device__ __forceinline__ void thin_gemm(const bf16_t* A, int lda, const bf16_t* Bt, int K, bf16_t* O, int ldc, bf16_t* P, unsigned char* lds) {
    const int tid = otid(), lane = tid & 63, w = tid >> 6, l31 = lane & 31, hi = lane >> 5;
    float* red = (float*)lds;
    for (int piece = blockIdx.x; piece < 256; piece += gridDim.x) {
        const int m0 = MAIN_ROWS + 32 * (piece >> 5), n0 = 32 * (piece & 31);
        const int kw = K >> 3, kb = w * kw;
        const bf16_t* ap = A + (size_t)(m0 + l31) * lda + kb + 8 * hi;
        const bf16_t* bp = Bt + (size_t)(n0 + l31) * K + kb + 8 * hi;
        f32x16 acc;
#pragma unroll
        for (int r = 0; r < 16; ++r) acc[r] = 0.f;
        bf16x8 wfr[NS], afr[NS];
#pragma unroll
        for (int s = 0; s < NS; ++s) { wfr[s] = *(const bf16x8*)(bp + 16 * s); afr[s] = *(const bf16x8*)(ap + 16 * s); }
#pragma unroll
        for (int s = 0; s < NS; ++s) acc = __builtin_amdgcn_mfma_f32_32x32x16_bf16(wfr[s], afr[s], acc, 0, 0, 0);
#pragma unroll
        for (int r = 0; r < 16; ++r) red[(w * 16 + r) * 64 + lane] = acc[r];
        __syncthreads();
        float v0 = 0.f, v1 = 0.f;
#pragma unroll
        for (int ww = 0; ww < 8; ++ww) { v0 += red[(ww * 16 + 2 * w) * 64 + lane]; v1 += red[(ww * 16 + 2 * w + 1) * 64 + lane]; }
        const int m = m0 + l31, n = n0 + ((2 * w) & 3) + 8 * ((2 * w) >> 2) + 4 * hi;
        if (EPI == 0) { *(unsigned*)(O + (size_t)m * ldc + n) = cvt_pk_bf16(v0, v1); }
        else { bf16_t* rowp = P + (size_t)m * PP + n; const unsigned gq = *(const unsigned*)(rowp + (EPI == 1 ? C_GTA : C_GTB));
            const float g0 = __uint_as_float(gq << 16), g1 = __uint_as_float(gq & 0xffff0000u);
            float t0 = 0.f, t1 = 0.f; if (EPI == 2) { const unsigned tq = *(const unsigned*)(rowp + C_YM); t0 = __uint_as_float(tq << 16); t1 = __uint_as_float(tq & 0xffff0000u); }
            *(unsigned*)(rowp + C_YM) = cvt_pk_bf16(t0 + v0 * g0, t1 + v1 * g1); }
        __syncthreads();
    }
}

#define XB_TMO      128
#define XB_XCNT(j)  (256  + 64 * (j))
#define XB_XSUB(j)  (1280 + 64 * (j))
#define XB_XGEN(j)  (2304 + 64 * (j))
#define XB_TOP      3328
#define XB_TOPGEN   3392
#define XCD_BAR_WORDS 3456
#define XB_SPIN_CAP (1u << 18)
#define LAS __attribute__((address_space(3)))

__device__ __forceinline__ unsigned xb_ld(unsigned* p)              { return __hip_atomic_load(p, __ATOMIC_RELAXED, __HIP_MEMORY_SCOPE_AGENT); }
__device__ __forceinline__ unsigned xb_add(unsigned* p, unsigned v) { return __hip_atomic_fetch_add(p, v, __ATOMIC_RELAXED, __HIP_MEMORY_SCOPE_AGENT); }
__device__ __forceinline__ unsigned xb_xcc_id() { return (unsigned)__builtin_amdgcn_s_getreg((3 << 11) | 20) & 0xFu; }
#define XB_SPIN(cond, bar) do { unsigned _sp = 0; while (cond) { __builtin_amdgcn_s_sleep(1); \
    if ((++_sp & 255u) == 0u) { if (xb_ld(&(bar)[XB_TMO])) break; if (_sp > XB_SPIN_CAP) { atomicAdd(&(bar)[XB_TMO], 1u); break; } } } } while (0)

struct XcdBarrier {
    unsigned* bar; unsigned x;
    volatile LAS unsigned* st;
};

__device__ unsigned g_bar[XCD_BAR_WORDS + 64];
__device__ __forceinline__ XcdBarrier xcd_barrier_post(unsigned* bar, volatile LAS unsigned* st) {
    XcdBarrier b; b.bar = bar; b.x = xb_xcc_id(); b.st = st;
    if (threadIdx.x == 0) (void)xb_add(&bar[XB_XCNT(b.x)], 1u);
    return b;
}
__device__ __forceinline__ void xcd_barrier_complete(unsigned* bar, unsigned x, unsigned& nloc, unsigned& nx) {
    const unsigned G = gridDim.x * gridDim.y * gridDim.z;
    unsigned sum, cnt, mine, sp = 0u;
    for (;;) {
        sum = 0u; cnt = 0u; mine = 0u;
#pragma unroll
        for (unsigned j = 0; j < 16; ++j) { const unsigned c = xb_ld(&bar[XB_XCNT(j)]); sum += c; cnt += (c > 0u) ? 1u : 0u; mine = (j == x) ? c : mine; }
        if (sum == G) break;
        __builtin_amdgcn_s_sleep(1);
        if ((++sp & 255u) == 0u) { if (xb_ld(&bar[XB_TMO])) break; if (sp > XB_SPIN_CAP) { atomicAdd(&bar[XB_TMO], 1u); break; } }
    }
    nloc = mine > 0u ? mine : 1u; nx = cnt > 0u ? cnt : 1u;
}

__device__ __forceinline__ void xcd_barrier(const XcdBarrier& b) {
    asm volatile("s_waitcnt vmcnt(0)" ::: "memory");
    __syncthreads();
    if (threadIdx.x == 0) {
        unsigned* bar = b.bar;
        __builtin_amdgcn_s_waitcnt(0);
        unsigned nloc = b.st[0], nx = b.st[1];
        if (nloc == 0u) { xcd_barrier_complete(bar, b.x, nloc, nx); b.st[0] = nloc; b.st[1] = nx; }
        const unsigned old = xb_add(&bar[XB_XSUB(b.x)], 1u);
        const unsigned gen = old / nloc;
        if (old + 1u == (gen + 1u) * nloc) {
            __builtin_amdgcn_fence(__ATOMIC_RELEASE, "agent");
            asm volatile("s_waitcnt vmcnt(0)" ::: "memory");
            const unsigned og = xb_add(&bar[XB_TOP], 1u);
            const unsigned tg = og / nx;
            if (og + 1u == (tg + 1u) * nx) xb_add(&bar[XB_TOPGEN], 1u);
            else XB_SPIN(xb_ld(&bar[XB_TOPGEN]) == tg, bar);
            __builtin_amdgcn_fence(__ATOMIC_ACQUIRE, "agent");
            xb_add(&bar[XB_XGEN(b.x)], 1u);
            asm volatile("s_waitcnt vmcnt(0)" ::: "memory");
        } else {
            XB_SPIN(xb_ld(&bar[XB_XGEN(b.x)]) == gen, bar);
            __builtin_amdgcn_fence(__ATOMIC_ACQUIRE, "agent");
            asm volatile("s_waitcnt vmcnt(0)" ::: "memory");
        }
    }
    __syncthreads();
}


__global__ void __launch_bounds__(NTHREADS, 2) fwd_megakernel(Args ar) {
    extern __shared__ __attribute__((aligned(16))) unsigned char lds[];
    cg::grid_group grid = cg::this_grid();
    if (gridDim.x == 0x7fffffffu) grid.sync();
    { const int t0_ = otid(); if (t0_ < 4) ((PG8_LAS unsigned*)(lds + LDS_MAIN))[t0_] = 0u; }
    __syncthreads();
    const XcdBarrier xbar = xcd_barrier_post(g_bar, (volatile LAS unsigned*)(PG8_LAS unsigned*)(lds + LDS_MAIN));
#ifdef PROBE_SYNC
#define GSYNC() do { xcd_barrier(xbar); xcd_barrier(xbar); } while (0)
#else
#define GSYNC() xcd_barrier(xbar)
#endif
    PG8_LAS unsigned char* lds3 = (PG8_LAS unsigned char*)lds;
    unsigned char* ws = ar.ws;
    bf16_t* R1 = (bf16_t*)(ws + WS_R1); bf16_t* R2 = (bf16_t*)(ws + WS_R2);
    float* LF = (float*)(ws + WS_LF); float* GA = (float*)(ws + WS_GA); float* CUM = (float*)(ws + WS_CUM); unsigned* KMAXW = (unsigned*)(ws + WS_KMAX);
    const int G = gridDim.x, cblk = blockIdx.x;

#pragma unroll 1
    for (int it = 0; it <= DEPTH; ++it) {
      const int layer = it - 1;
      if (layer >= 0) {
#pragma unroll 1
        for (int ffn = 0; ffn < 2; ++ffn) {
            if (ffn == 1) {
                { const int t0_ = otid(); if (cblk == 0 && t0_ < 16) KMAXW[t0_] = 0u; }
                { pg8::Gemm g{R1, (const bf16_t*)(ws + WS_WIN), MR, NINP, DM, DM}; pg8::StaticOrder S; S.init(MR, NINP, G, cblk);
                  pg8::EpiInProj E{R2, LF, GA, ar.b_f + layer * 8};
                  pg8::gemm_phase<pg8::EpiInProj, pg8::StaticOrder, true, true>(lds3, g, S, E); }
                GSYNC();
                cumsum_phase(LF, CUM, lds);
                kmax_phase(R2, KMAXW, lds);
                for (int u = cblk; u < 8 * 64; u += G) gla_g1_unit(u >> 8, (u >> 6) & 3, u & 63, ar, layer, lds);
#ifdef PROBE_G1
                for (int u = cblk; u < 8 * 64; u += G) gla_g1_unit(u >> 8, (u >> 6) & 3, u & 63, ar, layer, lds);
#endif
                GSYNC();
                gla_g2_phase(ar);
                if (G >= 136) { if (cblk >= 128 && cblk < 136) gla_g3_unit((cblk - 128) >> 2, (cblk - 128) & 3, 0, ar, layer, lds, false); }
                else if (cblk == 0) { for (int u = 0; u < 8; ++u) gla_g3_unit(u >> 2, u & 3, 0, ar, layer, lds, false); }
#ifdef PROBE_ATTN
                attn_phase(R2, CUM, KMAXW, lds, true);
#endif
                attn_phase(R2, CUM, KMAXW, lds, false);
                GSYNC();
#ifdef PROBE_G3
                for (int u = cblk; u < 8 * 64; u += G) gla_g3_unit(u >> 8, (u >> 6) & 3, 1 + (u & 63), ar, layer, lds, true);
#endif
                for (int u = cblk; u < 8 * 64; u += G) gla_g3_unit(u >> 8, (u >> 6) & 3, 1 + (u & 63), ar, layer, lds, false);
                { pg8::Gemm g{R2 + C_FQ, (const bf16_t*)(ws + WS_WFO), MAIN_ROWS, DM, 512, PP}; pg8::StaticOrder S; S.init(MAIN_ROWS, DM, G, cblk);
                  pg8::EpiMerge1 E{R2};
                  pg8::gemm_phase<pg8::EpiMerge1, pg8::StaticOrder, true, true>(lds3, g, S, E); }
                thin_gemm<1, 4>(R2 + C_FQ, PP, (const bf16_t*)(ws + WS_WFO), 512, nullptr, 0, R2, lds);
                GSYNC();
                { pg8::Gemm g{R2 + C_GR, (const bf16_t*)(ws + WS_WGO), MAIN_ROWS, DM, 512, PP}; pg8::StaticOrder S; S.init(MAIN_ROWS, DM, G, cblk);
                  pg8::EpiMerge2 E{R2};
                  pg8::gemm_phase<pg8::EpiMerge2, pg8::StaticOrder, true, true>(lds3, g, S, E); }
                thin_gemm<2, 4>(R2 + C_GR, PP, (const bf16_t*)(ws + WS_WGO), 512, nullptr, 0, R2, lds);
                GSYNC();
                { pg8::Gemm g{R2 + C_YM, (const bf16_t*)(ws + WS_WOUT), MAIN_ROWS, DM, DM, PP}; pg8::StaticOrder S; S.init(MAIN_ROWS, DM, G, cblk);
                  pg8::EpiPlain E{R1, DM};
                  pg8::gemm_phase<pg8::EpiPlain, pg8::StaticOrder, true, true>(lds3, g, S, E); }
                thin_gemm<0, 8>(R2 + C_YM, PP, (const bf16_t*)(ws + WS_WOUT), DM, R1, DM, nullptr, lds);
                GSYNC();
#ifdef PROBE_NORM
                norm_phase<1>(ar, R1, R1, 1.0f, ar.g_postm + layer * DM, ar.g_pre2 + layer * DM, true);
#endif
                norm_phase<1>(ar, R1, R1, 1.0f, ar.g_postm + layer * DM, ar.g_pre2 + layer * DM);
                GSYNC();
            }
            { pg8::Gemm g{R1, (const bf16_t*)(ws + (ffn ? WS_WGU2 : WS_WGU1)), MR, NGU, DM, DM}; pg8::StaticOrder S; S.init(MR, NGU, G, cblk);
              pg8::EpiSwiglu E{R2, DFF};
              pg8::gemm_phase<pg8::EpiSwiglu, pg8::StaticOrder, true, true>(lds3, g, S, E);
#ifdef PROBE_GU
              __syncthreads(); pg8::gemm_phase<pg8::EpiSwiglu, pg8::StaticOrder, true, true>(lds3, g, S, E);
#endif
            }
            GSYNC();
            { pg8::Gemm g{R2, (const bf16_t*)(ws + (ffn ? WS_WD2 : WS_WD1)), MAIN_ROWS, DM, DFF, DFF}; pg8::StaticOrder S; S.init(MAIN_ROWS, DM, G, cblk);
              pg8::EpiPlain E{R1, DM};
              pg8::gemm_phase<pg8::EpiPlain, pg8::StaticOrder, true, true>(lds3, g, S, E);
#ifdef PROBE_DOWN
              __syncthreads(); pg8::gemm_phase<pg8::EpiPlain, pg8::StaticOrder, true, true>(lds3, g, S, E);
#endif
            }
            thin_gemm<0, 22>(R2, DFF, (const bf16_t*)(ws + (ffn ? WS_WD2 : WS_WD1)), DFF, R1, DM, nullptr, lds);
#ifdef PROBE_THIN
            thin_gemm<0, 22>(R2, DFF, (const bf16_t*)(ws + (ffn ? WS_WD2 : WS_WD1)), DFF, R1, DM, nullptr, lds);
#endif
            GSYNC();
#ifdef PROBE_NORM
            norm_phase<1>(ar, R1, R1, 0.5f, ar.g_post1 + layer * DM, ar.g_prem + layer * DM, true);
#endif
            if (ffn == 0) norm_phase<1>(ar, R1, R1, 0.5f, ar.g_post1 + layer * DM, ar.g_prem + layer * DM);
            else norm_phase<1>(ar, R1, R1, 0.5f, ar.g_post2 + layer * DM, layer + 1 < DEPTH ? ar.g_pre1 + (layer + 1) * DM : nullptr);
            if (ffn == 0) GSYNC();
        }
      }
      if (it < DEPTH) convert_phase(ar, it, lds);
      if (it == 0) norm_phase<0>(ar, nullptr, R1, 0.f, nullptr, ar.g_pre1);
      if (it < DEPTH) GSYNC();
    }
    __syncthreads();
    { const int t = otid(); PG8_LAS unsigned* flag = (PG8_LAS unsigned*)(lds + LDS_MAIN) + 2;
      if (t == 0) { const unsigned old = __hip_atomic_fetch_add(&g_bar[XCD_BAR_WORDS], 1u, __ATOMIC_RELAXED, __HIP_MEMORY_SCOPE_AGENT); flag[0] = (old + 1u == gridDim.x) ? 1u : 0u; }
      __syncthreads();
      if (flag[0]) { for (int i = t; i < XCD_BAR_WORDS + 64; i += NTHREADS) __hip_atomic_store(&g_bar[i], 0u, __ATOMIC_RELAXED, __HIP_MEMORY_SCOPE_AGENT); } }
}

extern "C" void kernel_launch(void* const* d_in, const int* in_sizes, int n_in, void* d_out, int out_size, void* d_ws, size_t ws_size, hipStream_t stream) {
    static int grid = 0;
    if (grid == 0) {
        if (n_in != 20 || out_size != NB * SEQ * DM || ws_size < WS_END) { fprintf(stderr, "kernel_launch: unexpected shapes (n_in %d, out %d, ws %zu < %zu); nothing launched\n", n_in, out_size, ws_size, (size_t)WS_END); grid = -1; return; }
        int dev = 0, cus = 0, per_cu = 0;
        hipGetDevice(&dev); hipDeviceGetAttribute(&cus, hipDeviceAttributeMultiprocessorCount, dev);
        if (hipFuncSetAttribute((const void*)fwd_megakernel, hipFuncAttributeMaxDynamicSharedMemorySize, LDS_BYTES) != hipSuccess) { fprintf(stderr, "kernel_launch: hipFuncSetAttribute failed\n"); grid = -1; return; }
        if (hipOccupancyMaxActiveBlocksPerMultiprocessor(&per_cu, (const void*)fwd_megakernel, NTHREADS, LDS_BYTES) != hipSuccess || per_cu < 1) per_cu = 1;
        (void)hipGetLastError();
        grid = cus > 0 ? cus : 256;
    }
    if (grid < 0) return;
    Args a{};
    const float* const* in = (const float* const*)d_in;
    a.x = in[0]; a.meta = in[1]; a.w_in = in[2]; a.w_alpha_up = in[3]; a.b_alpha = in[4]; a.b_f = in[5]; a.g_gla_out = in[6]; a.w_fox_o = in[7]; a.w_gla_o = in[8]; a.w_out = in[9];
    a.w_gu1 = in[10]; a.w_d1 = in[11]; a.w_gu2 = in[12]; a.w_d2 = in[13]; a.g_pre1 = in[14]; a.g_post1 = in[15]; a.g_prem = in[16]; a.g_postm = in[17]; a.g_pre2 = in[18]; a.g_post2 = in[19];
    a.out = (float*)d_out; a.ws = (unsigned char*)d_ws;
    void* args[] = {&a};
    hipError_t e = hipLaunchCooperativeKernel((const void*)fwd_megakernel, dim3(grid), dim3(NTHREADS), args, LDS_BYTES, stream);
    if (e != hipSuccess) fprintf(stderr, "cooperative launch failed: %s (grid %d)\n", hipGetErrorString(e), grid);
}
```

```cpp
#include <hip/hip_runtime.h>
#include <hip/hip_cooperative_groups.h>
#include <cstdio>
#include <cstdint>
namespace cg = cooperative_groups;

constexpr int DM = 1024, NB = 2, SEQ = 8192, DEPTH = 2, NMETA = 16, BLK = 128, NPAD = 112;
constexpr int LP = SEQ + BLK;
constexpr int MR = NB * LP;
constexpr int DFF = 2816, NGU = 2 * DFF;
constexpr int NIN = 5144, NINP = 5376;
constexpr int PP = 5120;
constexpr int C_FQ = 0, C_FK = 512, C_FV = 1024, C_GQ = 1536, C_GK = 1792, C_GV = 2048, C_GR = 2560, C_GTA = 3072, C_GTB = 4096, C_YM = 512;
constexpr int NCH = LP / BLK;
constexpr float RMS_EPS = 1e-6f;
constexpr float LOG2E = 1.4426950408889634f;
constexpr float QSCALE = 0.125f * LOG2E;
namespace pg8 {
#define PG8_LAS __attribute__((address_space(3)))
typedef unsigned short bf16_t;
typedef short bf16x8 __attribute__((ext_vector_type(8)));
typedef float f32x4 __attribute__((ext_vector_type(4)));
typedef unsigned u32x4 __attribute__((ext_vector_type(4)));
constexpr int BM = 256, BK = 64, HALF = 128, HTB = HALF * BK * 2  , STAGE_BYTES = 8 * HTB, NXCD = 8, WGM = 4;

__host__ __device__ __forceinline__ int lds_byte(int r, int c) { const int st = (r >> 4) * 2 + (c >> 5), rr = r & 15, cc = c & 31, ob = rr * 64 + cc * 2; return st * 1024 + (ob ^ (((ob >> 9) & 1) << 5)); }
__host__ __device__ __forceinline__ void stage_rc(int b, int& R, int& C) { const int st = b / 1024, sb = b % 1024, swz = sb ^ (((sb >> 9) & 1) << 5); R = (st >> 1) * 16 + swz / 64; C = (st & 1) * 32 + (swz % 64) / 2; }
__host__ __device__ __forceinline__ int perm32(int rho) { const int n = rho >> 4, i = rho & 15; return 8 * (i >> 2) + 4 * n + (i & 3); }

struct Unit { int pm, pn; };
struct Gemm { const bf16_t* A; const bf16_t* Bt; int M, N, K, lda; };

struct StaticOrder {
    int nM, nN, nwg, G, c;
    __host__ __device__ void init(int M, int N, int G_, int c_) { nM = M / BM; nN = N / BM; nwg = nM * nN; G = G_; c = c_; }
    __host__ __device__ bool next(int i, Unit& u) const {
        const long L = (long)i * G + c; if (L >= nwg) return false;
        int wgid = (int)L; { const int q = nwg / NXCD, r = nwg % NXCD, xcd = wgid % NXCD, off = wgid / NXCD; wgid = (xcd < r ? xcd * (q + 1) : r * (q + 1) + (xcd - r) * q) + off; }
        const int nig = WGM * nN, gid = wgid / nig, fm = gid * WGM, gsz = (nM - fm) < WGM ? (nM - fm) : WGM;
        u.pm = fm + ((wgid % nig) % gsz); u.pn = (wgid % nig) / gsz; return true;
    }
    __device__ __forceinline__ void a_ready(const Unit&) const {}
    __device__ __forceinline__ void done(const Unit&) const {}
};

__device__ __forceinline__ unsigned cvt_pk_bf16(float lo, float hi) { unsigned r; asm volatile("v_cvt_pk_bf16_f32 %0, %1, %2" : "=v"(r) : "v"(lo), "v"(hi)); return r; }
typedef float f32x2 __attribute__((ext_vector_type(2)));
__device__ __forceinline__ float bf2f(unsigned short v) { return __uint_as_float(((unsigned)v) << 16); }
__device__ __forceinline__ float fsigmoid(float x) { return __builtin_amdgcn_rcpf(1.0f + __expf(-x)); }
__device__ __forceinline__ float fsilu(float x) { return x * fsigmoid(x); }
__device__ __forceinline__ float logsigmoidf(float x) { return fminf(x, 0.f) - __logf(1.0f + __expf(-fabsf(x))); }
__device__ __forceinline__ u32x4 pack8(const f32x4 v0, const f32x4 v1) { u32x4 w; w.x = cvt_pk_bf16(v0[0], v0[1]); w.y = cvt_pk_bf16(v0[2], v0[3]); w.z = cvt_pk_bf16(v1[0], v1[1]); w.w = cvt_pk_bf16(v1[2], v1[3]); return w; }
__device__ __forceinline__ void unpack8(const u32x4 w, f32x4& v0, f32x4& v1) {
    v0[0] = __uint_as_float(w.x << 16); v0[1] = __uint_as_float(w.x & 0xffff0000u); v0[2] = __uint_as_float(w.y << 16); v0[3] = __uint_as_float(w.y & 0xffff0000u);
    v1[0] = __uint_as_float(w.z << 16); v1[1] = __uint_as_float(w.z & 0xffff0000u); v1[2] = __uint_as_float(w.w << 16); v1[3] = __uint_as_float(w.w & 0xffff0000u); }

struct EpiPlain {
    static constexpr bool PERM = true, AFTER_DRAIN = false;
    bf16_t* O; int ldc;
    __device__ __forceinline__ void operator()(const f32x4 (&acc)[2][2][4][2], const Unit& u, int wr, int wc, int fr, int fq) const {
        const int row0 = u.pm * BM + wr * 64 + fr, col0 = u.pn * BM + wc * 32 + 8 * fq;
#pragma unroll
        for (int ai = 0; ai < 2; ++ai)
#pragma unroll
            for (int m = 0; m < 4; ++m) { bf16_t* rowp = O + (size_t)(row0 + ai * HALF + m * 16) * ldc + col0;
#pragma unroll
                for (int bj = 0; bj < 2; ++bj) *(u32x4*)(rowp + bj * HALF) = pack8(acc[ai][bj][m][0], acc[ai][bj][m][1]); }
    }
};
struct EpiSwiglu {
    static constexpr bool PERM = true, AFTER_DRAIN = false;
    bf16_t* O; int ldc;
    __device__ __forceinline__ void operator()(const f32x4 (&acc)[2][2][4][2], const Unit& u, int wr, int wc, int fr, int fq) const {
        const int row0 = u.pm * BM + wr * 64 + fr, col0 = u.pn * HALF + wc * 32 + 8 * fq;
#pragma unroll
        for (int ai = 0; ai < 2; ++ai)
#pragma unroll
            for (int m = 0; m < 4; ++m) { bf16_t* rowp = O + (size_t)(row0 + ai * HALF + m * 16) * ldc + col0;
                f32x4 o0, o1;
#pragma unroll
                for (int i = 0; i < 4; ++i) { o0[i] = fsilu(acc[ai][0][m][0][i]) * acc[ai][1][m][0][i]; o1[i] = fsilu(acc[ai][0][m][1][i]) * acc[ai][1][m][1][i]; }
                *(u32x4*)rowp = pack8(o0, o1); }
    }
};
struct EpiInProj {
    static constexpr bool PERM = true, AFTER_DRAIN = false;
    bf16_t* P; float* LF; float* GA; const float* b_f;
    __device__ __forceinline__ void operator()(const f32x4 (&acc)[2][2][4][2], const Unit& u, int wr, int wc, int fr, int fq) const {
        const int pn = u.pn; const int row0 = u.pm * BM + wr * 64 + fr;
        if (pn < 20) {
            const int mode = pn < 2 ? 1 : (pn == 6 ? 1 : (pn < 10 ? 0 : (pn < 12 ? 2 : 3)));
            const float sc = pn < 2 ? QSCALE : 0.125f;
            const int col0 = pn * BM + wc * 32 + 8 * fq;
#pragma unroll
            for (int ai = 0; ai < 2; ++ai)
#pragma unroll
                for (int m = 0; m < 4; ++m) { bf16_t* rowp = P + (size_t)(row0 + ai * HALF + m * 16) * PP + col0;
#pragma unroll
                    for (int bj = 0; bj < 2; ++bj) { f32x4 v0 = acc[ai][bj][m][0], v1 = acc[ai][bj][m][1];
                        if (mode == 1) { v0 = v0 * sc; v1 = v1 * sc; }
                        else if (mode == 2) {
#pragma unroll
                            for (int i = 0; i < 4; ++i) { v0[i] = fsilu(v0[i]); v1[i] = fsilu(v1[i]); } }
                        else if (mode == 3) {
#pragma unroll
                            for (int i = 0; i < 4; ++i) { v0[i] = fsigmoid(v0[i]); v1[i] = fsigmoid(v1[i]); } }
                        *(u32x4*)(rowp + bj * HALF) = pack8(v0, v1); } }
        } else if (wc == 0 && fq < 3) {
#pragma unroll
            for (int ai = 0; ai < 2; ++ai)
#pragma unroll
                for (int m = 0; m < 4; ++m) { const int r = row0 + ai * HALF + m * 16; const int p = r >= LP ? r - LP : r;
                    f32x4 v0 = acc[ai][0][m][0], v1 = acc[ai][0][m][1];
                    if (fq == 0) { const float valid = p >= NPAD ? 1.f : 0.f;
#pragma unroll
                        for (int i = 0; i < 4; ++i) { v0[i] = logsigmoidf(v0[i] + b_f[i]) * valid; v1[i] = logsigmoidf(v1[i] + b_f[4 + i]) * valid; }
                        *(f32x4*)(LF + (size_t)r * 8) = v0; *(f32x4*)(LF + (size_t)r * 8 + 4) = v1;
                    } else { float* g = GA + (size_t)r * 16 + 8 * (fq - 1); *(f32x4*)g = v0; *(f32x4*)(g + 4) = v1; } }
        }
    }
};
struct EpiMerge1 {
    static constexpr bool PERM = true, AFTER_DRAIN = false;
    bf16_t* P;
    __device__ __forceinline__ void operator()(const f32x4 (&acc)[2][2][4][2], const Unit& u, int wr, int wc, int fr, int fq) const {
        const int row0 = u.pm * BM + wr * 64 + fr, col0 = u.pn * BM + wc * 32 + 8 * fq;
#pragma unroll
        for (int ai = 0; ai < 2; ++ai)
#pragma unroll
            for (int m = 0; m < 4; ++m) { bf16_t* rowp = P + (size_t)(row0 + ai * HALF + m * 16) * PP + col0;
#pragma unroll
                for (int bj = 0; bj < 2; ++bj) { f32x4 g0, g1; unpack8(*(const u32x4*)(rowp + C_GTA + bj * HALF), g0, g1);
                    *(u32x4*)(rowp + C_YM + bj * HALF) = pack8(acc[ai][bj][m][0] * g0, acc[ai][bj][m][1] * g1); } }
    }
};
struct EpiMerge2 {
    static constexpr bool PERM = true, AFTER_DRAIN = false;
    bf16_t* P;
    __device__ __forceinline__ void operator()(const f32x4 (&acc)[2][2][4][2], const Unit& u, int wr, int wc, int fr, int fq) const {
        const int row0 = u.pm * BM + wr * 64 + fr, col0 = u.pn * BM + wc * 32 + 8 * fq;
#pragma unroll
        for (int ai = 0; ai < 2; ++ai)
#pragma unroll
            for (int m = 0; m < 4; ++m) { bf16_t* rowp = P + (size_t)(row0 + ai * HALF + m * 16) * PP + col0;
#pragma unroll
                for (int bj = 0; bj < 2; ++bj) { f32x4 g0, g1, t0, t1; unpack8(*(const u32x4*)(rowp + C_GTB + bj * HALF), g0, g1); unpack8(*(const u32x4*)(rowp + C_YM + bj * HALF), t0, t1);
                    *(u32x4*)(rowp + C_YM + bj * HALF) = pack8(t0 + acc[ai][bj][m][0] * g0, t1 + acc[ai][bj][m][1] * g1); } }
    }
};

template <class Epi, class Sched, bool ALIGN_EPI = false, bool SP2 = false>
__device__ __forceinline__ void gemm_phase(PG8_LAS unsigned char* lds, const Gemm g, const Sched& S, const Epi& E) {
    int tid_ = threadIdx.x; asm volatile("" : "+v"(tid_)); const int tid = tid_, wid = __builtin_amdgcn_readfirstlane(tid >> 6), lane = tid & 63, wr = wid >> 2, wc = wid & 3, fr = lane & 15, fq = lane >> 4;
    const int K = g.K, nt = K / BK;
    unsigned voffA[2], voffB[2];
#pragma unroll
    for (int i = 0; i < 2; ++i) { int R, C; stage_rc(tid * 16 + i * 8192, R, C); const int Rb = Epi::PERM ? ((R & ~31) + perm32(R & 31)) : R;
        voffA[i] = (unsigned)(R * g.lda + C) * 2u; voffB[i] = (unsigned)(Rb * K + C) * 2u; }
    const size_t kstep = (size_t)(BK * 2);
    const size_t hstep = (size_t)HALF * K * 2;
    const size_t tstep = 2 * hstep; const size_t hstepA = (size_t)HALF * g.lda * 2, tstepA = 2 * hstepA;
    const unsigned ldsw = (unsigned)wid * 1024u;
    const int aoff = lds_byte(wr * 64 + fr, fq * 8), boff = lds_byte(wc * 32 + fr, fq * 8);
#define PG8_SA(b, h) (((b) * 2 + (h)) * HTB)
#define PG8_SB(b, h) ((4 + (b) * 2 + (h)) * HTB)
#define PG8_STAGE(bufoff, gbase, voff) do { _Pragma("unroll") for (int _i = 0; _i < 2; ++_i) \
        __builtin_amdgcn_global_load_lds((const unsigned*)((const char*)(gbase) + (voff)[_i]), (PG8_LAS unsigned*)(lds + (bufoff) + ldsw + _i * 8192), 16, 0, 0); } while (0)
#define PG8_LDA(dst, b, h) do { _Pragma("unroll") for (int m = 0; m < 4; ++m) _Pragma("unroll") for (int k = 0; k < 2; ++k) dst[m][k] = *(const PG8_LAS bf16x8*)(lds + PG8_SA(b, h) + aoff + m * 2048 + k * 1024); } while (0)
#define PG8_LDB(dst, b, h) do { _Pragma("unroll") for (int n = 0; n < 2; ++n) _Pragma("unroll") for (int k = 0; k < 2; ++k) dst[n][k] = *(const PG8_LAS bf16x8*)(lds + PG8_SB(b, h) + boff + n * 2048 + k * 1024); } while (0)
#define PG8_MMA(ai, bj, At, Bt) do { __builtin_amdgcn_s_setprio(1); _Pragma("unroll") for (int m = 0; m < 4; ++m) _Pragma("unroll") for (int n = 0; n < 2; ++n) _Pragma("unroll") for (int k = 0; k < 2; ++k) \
        acc[ai][bj][m][n] = __builtin_amdgcn_mfma_f32_16x16x32_bf16(Bt[n][k], At[m][k], acc[ai][bj][m][n], 0, 0, 0); __builtin_amdgcn_s_setprio(0); } while (0)
#define PG8_WAIT_V(n) asm volatile("s_waitcnt vmcnt(" #n ")" ::: "memory")
#define PG8_WAIT_L(n) asm volatile("s_waitcnt lgkmcnt(" #n ")" ::: "memory")
#define PG8_BAR __builtin_amdgcn_s_barrier()
#define PG8_SCHED __builtin_amdgcn_sched_barrier(0)
    Unit cur, nxt; int ui = 0;
    if (!S.next(0, cur)) return;
    f32x4 acc[2][2][4][2];
#pragma unroll
    for (int a = 0; a < 2; ++a)
#pragma unroll
        for (int b = 0; b < 2; ++b)
#pragma unroll
            for (int m = 0; m < 4; ++m)
#pragma unroll
                for (int n = 0; n < 2; ++n) acc[a][b][m][n] = (f32x4){0.f, 0.f, 0.f, 0.f};
    bf16x8 At[4][2], B0[2][2], B1[2][2];
    const char* cA = (const char*)g.A + (size_t)cur.pm * tstepA; const char* cB = (const char*)g.Bt + (size_t)cur.pn * tstep;
    S.a_ready(cur);
    if constexpr (SP2) {
        PG8_STAGE(PG8_SB(0, 0), cB, voffB); PG8_STAGE(PG8_SB(0, 1), cB + hstep, voffB); PG8_STAGE(PG8_SA(0, 0), cA, voffA); PG8_STAGE(PG8_SA(0, 1), cA + hstepA, voffA);
        if (wr == 1) PG8_BAR;
        PG8_WAIT_V(2); PG8_BAR;
        PG8_STAGE(PG8_SB(1, 0), cB + kstep, voffB); PG8_STAGE(PG8_SA(1, 0), cA + kstep, voffA); PG8_STAGE(PG8_SB(1, 1), cB + hstep + kstep, voffB);
        PG8_WAIT_V(6); PG8_BAR;
    } else {
        PG8_STAGE(PG8_SB(0, 0), cB, voffB); PG8_STAGE(PG8_SA(0, 0), cA, voffA); PG8_STAGE(PG8_SB(0, 1), cB + hstep, voffB); PG8_STAGE(PG8_SA(0, 1), cA + hstepA, voffA);
        if (wr == 1) PG8_BAR;
        PG8_WAIT_V(4); PG8_BAR;
        PG8_STAGE(PG8_SB(1, 0), cB + kstep, voffB); PG8_STAGE(PG8_SA(1, 0), cA + kstep, voffA); PG8_STAGE(PG8_SB(1, 1), cB + hstep + kstep, voffB);
        PG8_WAIT_V(6); PG8_BAR;
    }
    for (;;) {
        const bool has_next = S.next(ui + 1, nxt);
        const char* nA = has_next ? (const char*)g.A + (size_t)nxt.pm * tstepA : cA; const char* nB = has_next ? (const char*)g.Bt + (size_t)nxt.pn * tstep : cB;
        for (int t = 0; t < nt; t += 2) {
            const bool last = (t == nt - 2);
            const char* a1 = cA + (size_t)(t + 1) * kstep;
            const char* a2 = last ? nA : cA + (size_t)(t + 2) * kstep; const char* b2 = last ? nB : cB + (size_t)(t + 2) * kstep;
            const char* a3 = a2 + kstep; const char* b3 = b2 + kstep;
            if (last && has_next) S.a_ready(nxt);
            if constexpr (SP2) {
            PG8_LDB(B0, 0, 0); PG8_LDB(B1, 0, 1); PG8_SCHED; PG8_LDA(At, 0, 0); PG8_STAGE(PG8_SA(1, 1), a1 + hstepA, voffA);
            PG8_WAIT_V(8); PG8_WAIT_L(0); PG8_BAR; PG8_MMA(0, 0, At, B0); PG8_MMA(0, 1, At, B1); PG8_BAR; PG8_SCHED;
            PG8_LDA(At, 0, 1); PG8_STAGE(PG8_SB(0, 0), b2, voffB); PG8_STAGE(PG8_SB(0, 1), b2 + hstep, voffB); PG8_STAGE(PG8_SA(0, 0), a2, voffA);
            PG8_WAIT_V(8); PG8_WAIT_L(0); PG8_BAR; PG8_MMA(1, 0, At, B0); PG8_MMA(1, 1, At, B1); PG8_BAR; PG8_SCHED;
            PG8_LDB(B0, 1, 0); PG8_LDB(B1, 1, 1); PG8_SCHED; PG8_LDA(At, 1, 0); PG8_STAGE(PG8_SA(0, 1), a2 + hstepA, voffA);
            PG8_WAIT_V(8); PG8_WAIT_L(0); PG8_BAR; PG8_MMA(0, 0, At, B0); PG8_MMA(0, 1, At, B1); PG8_BAR; PG8_SCHED;
            PG8_LDA(At, 1, 1); PG8_STAGE(PG8_SB(1, 0), b3, voffB); PG8_STAGE(PG8_SB(1, 1), b3 + hstep, voffB); PG8_STAGE(PG8_SA(1, 0), a3, voffA);
            PG8_WAIT_V(8); PG8_WAIT_L(0); PG8_BAR; PG8_MMA(1, 0, At, B0); PG8_MMA(1, 1, At, B1); PG8_BAR; PG8_SCHED;
            } else {
            PG8_LDB(B0, 0, 0); PG8_SCHED; PG8_LDA(At, 0, 0); PG8_STAGE(PG8_SA(1, 1), a1 + hstepA, voffA);
            PG8_WAIT_L(8); PG8_BAR; PG8_WAIT_L(0); PG8_MMA(0, 0, At, B0); PG8_BAR; PG8_SCHED;
            PG8_LDB(B1, 0, 1); PG8_STAGE(PG8_SB(0, 0), b2, voffB);
            PG8_BAR; PG8_WAIT_L(0); PG8_MMA(0, 1, At, B1); PG8_BAR;
            PG8_LDA(At, 0, 1); PG8_STAGE(PG8_SA(0, 0), a2, voffA);
            PG8_BAR; PG8_WAIT_L(0); PG8_MMA(1, 0, At, B0); PG8_BAR; PG8_SCHED;
            PG8_STAGE(PG8_SB(0, 1), b2 + hstep, voffB);
            PG8_WAIT_V(6); PG8_BAR; PG8_MMA(1, 1, At, B1); PG8_BAR;
            PG8_LDB(B0, 1, 0); PG8_SCHED; PG8_LDA(At, 1, 0); PG8_STAGE(PG8_SA(0, 1), a2 + hstepA, voffA);
            PG8_WAIT_L(8); PG8_BAR; PG8_WAIT_L(0); PG8_MMA(0, 0, At, B0); PG8_BAR; PG8_SCHED;
            PG8_LDB(B1, 1, 1); PG8_STAGE(PG8_SB(1, 0), b3, voffB);
            PG8_BAR; PG8_WAIT_L(0); PG8_MMA(0, 1, At, B1); PG8_BAR;
            PG8_LDA(At, 1, 1); PG8_STAGE(PG8_SA(1, 0), a3, voffA);
            PG8_BAR; PG8_WAIT_L(0); PG8_MMA(1, 0, At, B0); PG8_BAR; PG8_SCHED;
            PG8_STAGE(PG8_SB(1, 1), b3 + hstep, voffB);
            PG8_WAIT_V(6); PG8_BAR; PG8_MMA(1, 1, At, B1); PG8_BAR;
            }
        }
        if constexpr (ALIGN_EPI) { if (wr == 0) PG8_BAR; }
        if constexpr (!Epi::AFTER_DRAIN) { E(acc, cur, wr, wc, fr, fq); S.done(cur); }
        if (!has_next) break;
#pragma unroll
        for (int a = 0; a < 2; ++a)
#pragma unroll
            for (int b = 0; b < 2; ++b)
#pragma unroll
                for (int m = 0; m < 4; ++m)
#pragma unroll
                    for (int n = 0; n < 2; ++n) acc[a][b][m][n] = (f32x4){0.f, 0.f, 0.f, 0.f};
        cur = nxt; cA = nA; cB = nB; ++ui;
        if constexpr (ALIGN_EPI) { if (wr == 1) PG8_BAR; }
    }
    PG8_WAIT_V(0);
    if constexpr (!ALIGN_EPI) { if (wr == 0) PG8_BAR; }
    PG8_BAR;
    if constexpr (Epi::AFTER_DRAIN) { E.fused(acc, cur, wr, wc, fr, fq, lds, wid, lane); S.done(cur); }
#undef PG8_SA
#undef PG8_SB
#undef PG8_STAGE
#undef PG8_LDA
#undef PG8_LDB
#undef PG8_MMA
#undef PG8_WAIT_V
#undef PG8_WAIT_L
#undef PG8_BAR
#undef PG8_SCHED
}
}

typedef unsigned short bf16_t;
typedef short bf16x8 __attribute__((ext_vector_type(8)));
typedef short s16x4 __attribute__((ext_vector_type(4)));
typedef float f32x4 __attribute__((ext_vector_type(4)));
typedef float f32x16 __attribute__((ext_vector_type(16)));
typedef unsigned u32x4 __attribute__((ext_vector_type(4)));
typedef unsigned u32x2 __attribute__((ext_vector_type(2)));
using pg8::bf2f; using pg8::cvt_pk_bf16; using pg8::fsigmoid; using pg8::logsigmoidf;

constexpr int NTHREADS = 512, NWAVES = 8;
constexpr int LDS_MAIN = 131072;
constexpr int LDS_BYTES = LDS_MAIN + 256;

constexpr size_t SZ_WGU = (size_t)NGU * DM * 2, SZ_WD = (size_t)DM * DFF * 2, SZ_WIN = (size_t)NINP * DM * 2, SZ_WO5 = (size_t)DM * 512 * 2, SZ_WOUT = (size_t)DM * DM * 2;
constexpr size_t WS_WGU1 = 0, WS_WD1 = WS_WGU1 + SZ_WGU, WS_WIN = WS_WD1 + SZ_WD, WS_WFO = WS_WIN + SZ_WIN, WS_WGO = WS_WFO + SZ_WO5, WS_WOUT = WS_WGO + SZ_WO5,
                 WS_WGU2 = WS_WOUT + SZ_WOUT, WS_WD2 = WS_WGU2 + SZ_WGU, WS_HM = WS_WD2 + SZ_WD;
constexpr size_t WS_LF = WS_HM + (size_t)NB * BLK * DM * 4;
constexpr size_t WS_GA = WS_LF + (size_t)MR * 8 * 4;
constexpr size_t WS_CUM = WS_GA + (size_t)MR * 16 * 4;
constexpr size_t WS_DEC = WS_CUM + (size_t)16 * LP * 4;
constexpr size_t WS_KMAX = WS_DEC + (size_t)8 * NCH * 64 * 4;
constexpr size_t WS_BAR = WS_KMAX + 256;
constexpr size_t WS_R1 = WS_BAR + 16384;
constexpr size_t WS_R2 = WS_R1 + (size_t)MR * DM * 2;
constexpr size_t WS_END = WS_R2 + (size_t)MR * PP * 2;
static_assert(WS_END <= (size_t)256 * 1024 * 1024, "workspace map exceeds 256 MiB");
static_assert((size_t)8 * NCH * 128 * 64 * 4 <= (size_t)MR * DM * 2, "GLA states must fit region R1");

struct Args {
    const float* x; const float* meta; const float* w_in; const float* w_alpha_up; const float* b_alpha; const float* b_f; const float* g_gla_out;
    const float* w_fox_o; const float* w_gla_o; const float* w_out; const float* w_gu1; const float* w_d1; const float* w_gu2; const float* w_d2;
    const float* g_pre1; const float* g_post1; const float* g_prem; const float* g_postm; const float* g_pre2; const float* g_post2;
    float* out; unsigned char* ws;
};

__device__ __forceinline__ float* hrow(float* out, float* hm, int r) {
    const int b = r >= LP ? 1 : 0, p = r - b * LP;
    return p < BLK ? hm + (size_t)(b * BLK + p) * DM : out + ((size_t)b * SEQ + (p - BLK)) * DM;
}
__device__ __forceinline__ int otid() { int t = threadIdx.x; asm volatile("" : "+v"(t)); return t; }
__device__ __forceinline__ float wave_sum(float v) {
#pragma unroll
    for (int o = 32; o > 0; o >>= 1) v += __shfl_xor(v, o);
    return v;
}

__device__ __forceinline__ int src_col(int kind, int n) {
    if (kind == 0) return n;
    if (kind == 1) { const int t = n >> 8, w = n & 255; return (w >> 7) * DFF + 128 * t + (w & 127); }
    if (n < 1536) return n;
    if (n < 2560) return n + 8;
    if (n < 5120) return n + 24;
    if (n < 5128) return n - 5120 + 1536;
    if (n < 5144) return n - 5128 + 2568;
    return -1;
}
constexpr int CT0 = 1408, CT1 = CT0 + 704, CT2 = CT1 + 1344, CT3 = CT2 + 128, CT4 = CT3 + 128, CT5 = CT4 + 256, CT6 = CT5 + 1408, CT7 = CT6 + 704;
__device__ __forceinline__ void conv_setup(const Args& ar, int layer, int t, int tid, const float*& lp, bool& ok, bf16_t*& sp) {
    unsigned char* ws = ar.ws;
    const float* src; bf16_t* dst; int K, ldsrc, kind, tt;
    if (t < CT0)      { src = ar.w_gu1 + (size_t)layer * DM * NGU;   dst = (bf16_t*)(ws + WS_WGU1); K = DM;  ldsrc = NGU; kind = 1; tt = t; }
    else if (t < CT1) { src = ar.w_d1 + (size_t)layer * DFF * DM;    dst = (bf16_t*)(ws + WS_WD1);  K = DFF; ldsrc = DM;  kind = 0; tt = t - CT0; }
    else if (t < CT2) { src = ar.w_in + (size_t)layer * DM * NIN;    dst = (bf16_t*)(ws + WS_WIN);  K = DM;  ldsrc = NIN; kind = 2; tt = t - CT1; }
    else if (t < CT3) { src = ar.w_fox_o + (size_t)layer * 512 * DM; dst = (bf16_t*)(ws + WS_WFO);  K = 512; ldsrc = DM;  kind = 0; tt = t - CT2; }
    else if (t < CT4) { src = ar.w_gla_o + (size_t)layer * 512 * DM; dst = (bf16_t*)(ws + WS_WGO);  K = 512; ldsrc = DM;  kind = 0; tt = t - CT3; }
    else if (t < CT5) { src = ar.w_out + (size_t)layer * DM * DM;    dst = (bf16_t*)(ws + WS_WOUT); K = DM;  ldsrc = DM;  kind = 0; tt = t - CT4; }
    else if (t < CT6) { src = ar.w_gu2 + (size_t)layer * DM * NGU;   dst = (bf16_t*)(ws + WS_WGU2); K = DM;  ldsrc = NGU; kind = 1; tt = t - CT5; }
    else              { src = ar.w_d2 + (size_t)layer * DFF * DM;    dst = (bf16_t*)(ws + WS_WD2);  K = DFF; ldsrc = DM;  kind = 0; tt = t - CT6; }
    const int nk = K >> 6, n0 = (tt / nk) << 6, k0 = (tt % nk) << 6;
    const int sc = src_col(kind, n0 + 8 * (tid & 7));
    ok = sc >= 0; lp = src + (size_t)(k0 + (tid >> 3)) * ldsrc + (ok ? sc : 0);
    sp = dst + (size_t)(n0 + (tid >> 3)) * K + k0 + 8 * (tid & 7);
}
__device__ __forceinline__ void convert_phase(const Args& ar, int layer, unsigned char* lds) {
    const int tid = otid(); const int kl = tid >> 3, c8 = tid & 7;
    const float* lp; bool ok; bf16_t* sp; f32x4 v0 = {0.f, 0.f, 0.f, 0.f}, v1 = v0;
    int t = blockIdx.x, buf = 0;
    if (t < CT7) { conv_setup(ar, layer, t, tid, lp, ok, sp); if (ok) { v0 = *(const f32x4*)lp; v1 = *(const f32x4*)(lp + 4); } else { v0 = (f32x4){0.f, 0.f, 0.f, 0.f}; v1 = v0; } }
#pragma unroll 1
    for (; t < CT7; t += gridDim.x) {
        bf16_t* T = (bf16_t*)(lds + buf * 9216);
        { const unsigned a = cvt_pk_bf16(v0[0], v0[1]), b = cvt_pk_bf16(v0[2], v0[3]), cc = cvt_pk_bf16(v1[0], v1[1]), d = cvt_pk_bf16(v1[2], v1[3]);
          bf16_t* q = T + (8 * c8) * 72 + (kl ^ (8 * c8));
          q[0] = (bf16_t)a; q[72] = (bf16_t)(a >> 16); q[144] = (bf16_t)b; q[216] = (bf16_t)(b >> 16); q[288] = (bf16_t)cc; q[360] = (bf16_t)(cc >> 16); q[432] = (bf16_t)d; q[504] = (bf16_t)(d >> 16); }
        __syncthreads();
        bf16_t* spc = sp;
        const int tn = t + gridDim.x;
        if (tn < CT7) { conv_setup(ar, layer, tn, tid, lp, ok, sp); if (ok) { v0 = *(const f32x4*)lp; v1 = *(const f32x4*)(lp + 4); } else { v0 = (f32x4){0.f, 0.f, 0.f, 0.f}; v1 = v0; } }
        *(u32x4*)spc = *(const u32x4*)(T + kl * 72 + ((8 * c8) ^ (8 * ((kl >> 3) & 7))));
        buf ^= 1;
    }
    __syncthreads();
}

template <int MODE>
__device__ __forceinline__ void norm_phase(const Args& ar, const bf16_t* y, bf16_t* a, float coef, const float* gpost, const float* gpre, const bool dry = false) {
    float* hm = (float*)(ar.ws + WS_HM);
    const int tid = otid(); const int lane = tid & 63, wv = tid >> 6;
    const int stride = gridDim.x * NWAVES;
    for (int r0 = blockIdx.x * NWAVES + wv; r0 < MR; r0 += 2 * stride) {
        const bool has1 = r0 + stride < MR; const int rr[2] = {r0, has1 ? r0 + stride : r0};
        f32x4 h[2][4], v[2][4]; float* hp[2];
#pragma unroll
        for (int q = 0; q < 2; ++q) { const int r = rr[q]; hp[q] = hrow(ar.out, hm, r); const int b = r >= LP ? 1 : 0, p = r - b * LP;
            if (MODE == 0) {
#pragma unroll
                for (int i = 0; i < 4; ++i) { const int c = 256 * i + 4 * lane;
                    if (p < NPAD) h[q][i] = (f32x4){0.f, 0.f, 0.f, 0.f};
                    else if (p < BLK) h[q][i] = *(const f32x4*)(ar.meta + (size_t)(p - NPAD) * DM + c);
                    else h[q][i] = *(const f32x4*)(ar.x + ((size_t)b * SEQ + (p - BLK)) * DM + c); }
            } else {
#pragma unroll
                for (int i = 0; i < 4; ++i) { const int c = 256 * i + 4 * lane; const u32x2 w = __builtin_nontemporal_load((const u32x2*)(y + (size_t)r * DM + c));
                    v[q][i][0] = __uint_as_float(w.x << 16); v[q][i][1] = __uint_as_float(w.x & 0xffff0000u); v[q][i][2] = __uint_as_float(w.y << 16); v[q][i][3] = __uint_as_float(w.y & 0xffff0000u);
                    h[q][i] = __builtin_nontemporal_load((const f32x4*)(hp[q] + c)); }
            } }
#pragma unroll
        for (int q = 0; q < 2; ++q) { if (q == 1 && !has1) break; const int r = rr[q];
            if (MODE == 1) { float ss = 0.f;
#pragma unroll
                for (int i = 0; i < 4; ++i) ss += v[q][i][0] * v[q][i][0] + v[q][i][1] * v[q][i][1] + v[q][i][2] * v[q][i][2] + v[q][i][3] * v[q][i][3];
                ss = wave_sum(ss); const float rs = coef * rsqrtf(ss * (1.0f / DM) + RMS_EPS);
#pragma unroll
                for (int i = 0; i < 4; ++i) { const int c = 256 * i + 4 * lane; const f32x4 g = *(const f32x4*)(gpost + c); h[q][i] = h[q][i] + v[q][i] * g * rs; } }
#pragma unroll
            for (int i = 0; i < 4; ++i) if (!dry) __builtin_nontemporal_store(h[q][i], (f32x4*)(hp[q] + 256 * i + 4 * lane));
            if (gpre) { float ss = 0.f;
#pragma unroll
                for (int i = 0; i < 4; ++i) ss += h[q][i][0] * h[q][i][0] + h[q][i][1] * h[q][i][1] + h[q][i][2] * h[q][i][2] + h[q][i][3] * h[q][i][3];
                ss = wave_sum(ss); const float rs = rsqrtf(ss * (1.0f / DM) + RMS_EPS);
#pragma unroll
                for (int i = 0; i < 4; ++i) { const int c = 256 * i + 4 * lane; const f32x4 g = *(const f32x4*)(gpre + c); const f32x4 o = h[q][i] * g * rs;
                    u32x2 w; w.x = cvt_pk_bf16(o[0], o[1]); w.y = cvt_pk_bf16(o[2], o[3]); if (!dry) *(u32x2*)(a + (size_t)r * DM + c) = w; } }
        }
    }
}

__device__ __forceinline__ void cumsum_phase(const float* LF, float* CUM, unsigned char* lds) {
    if (blockIdx.x >= 16) return;
    const int tid = otid(), lane = tid & 63, wv = tid >> 6, seq = blockIdx.x, b = seq >> 3, hh = seq & 7, p0 = 17 * tid;
    float* wt = (float*)lds;
    float v[17]; float s = 0.f;
#pragma unroll
    for (int i = 0; i < 17; ++i) { const int p = p0 + i; const float x = p < LP ? LF[(size_t)(b * LP + p) * 8 + hh] : 0.f; s += x; v[i] = s; }
    float sc = s;
#pragma unroll
    for (int o = 1; o < 64; o <<= 1) { const float t = __shfl_up(sc, o); if (lane >= o) sc += t; }
    if (lane == 63) wt[wv] = sc;
    __syncthreads();
    float off = sc - s;
#pragma unroll
    for (int w2 = 0; w2 < 8; ++w2) off += (w2 < wv) ? wt[w2] : 0.f;
#pragma unroll
    for (int i = 0; i < 17; ++i) { const int p = p0 + i; if (p < LP) CUM[(size_t)seq * LP + p] = v[i] + off; }
    __syncthreads();
}

constexpr float PRUNE_T = 40.0f;
__device__ __forceinline__ void kmax_phase(const bf16_t* P, unsigned* KMAX, unsigned char* lds) {
    const int tid = otid(), lane = tid & 63, wv = tid >> 6; float mx0 = 0.f, mx1 = 0.f;
    const int stride = gridDim.x * NWAVES;
    for (int rb = blockIdx.x * NWAVES + wv; rb < MR; rb += 9 * stride) {
        u32x4 kv9[9];
#pragma unroll
        for (int q = 0; q < 9; ++q) { const int r = rb + q * stride; kv9[q] = r < MR ? *(const u32x4*)(P + (size_t)r * PP + C_FK + 8 * lane) : (u32x4){0u, 0u, 0u, 0u}; }
#pragma unroll
        for (int q = 0; q < 9; ++q) { const int r = rb + q * stride; const u32x4 kv = kv9[q];
            const float a0 = __uint_as_float(kv.x << 16), a1 = __uint_as_float(kv.x & 0xffff0000u), a2 = __uint_as_float(kv.y << 16), a3 = __uint_as_float(kv.y & 0xffff0000u),
                        a4 = __uint_as_float(kv.z << 16), a5 = __uint_as_float(kv.z & 0xffff0000u), a6 = __uint_as_float(kv.w << 16), a7 = __uint_as_float(kv.w & 0xffff0000u);
            float ss = a0 * a0 + a1 * a1 + a2 * a2 + a3 * a3 + a4 * a4 + a5 * a5 + a6 * a6 + a7 * a7;
            ss += __shfl_xor(ss, 1); ss += __shfl_xor(ss, 2); ss += __shfl_xor(ss, 4);
            if (r >= LP) mx1 = fmaxf(mx1, ss); else mx0 = fmaxf(mx0, ss); }
    }
    float* red = (float*)lds;
    if ((lane & 7) == 0) { red[(lane >> 3) * 8 + wv] = mx0; red[64 + (lane >> 3) * 8 + wv] = mx1; }
    __syncthreads();
    if (tid < 16) { float m = 0.f;
#pragma unroll
        for (int i = 0; i < 8; ++i) m = fmaxf(m, red[tid * 8 + i]);
        atomicMax(KMAX + tid, __float_as_uint(m)); }
    __syncthreads();
}
__device__ __forceinline__ void attn_unit(int b, int hh, int qb, bf16_t* P, const float* CUM, const unsigned* KMAX, unsigned char* lds, const bool dry) {
    const int tid = otid(), lane = tid & 63, w = tid >> 6, g = w >> 2, wq = w & 3, l31 = lane & 31, hi = lane >> 5, gt = tid & 255;
    const size_t rowbase = (size_t)b * LP;
    const int qp = BLK * qb + 32 * wq + l31;
    const float* cum = CUM + (size_t)(b * 8 + hh) * LP;
    unsigned char* gl = lds + g * 40960;
    float* comb = (float*)(lds + 81920);
    float* misc = (float*)(lds + 116736);
    const bool active = (BLK * qb + 32 * wq + 31) >= NPAD;
    bf16x8 qf[4];
    { const bf16_t* qptr = P + (rowbase + qp) * PP + C_FQ + 64 * hh + 8 * hi;
#pragma unroll
      for (int s = 0; s < 4; ++s) qf[s] = *(const bf16x8*)(qptr + 16 * s); }
    const float ct = cum[qp] * LOG2E;
    const int jhi = 4 * qb + 3;
    const int srow = gt >> 3, sc8 = gt & 7;
    u32x4 kreg[2], vreg[2]; float csreg[2];
    const int vrow = gt & 31, vc8 = gt >> 5;
#define ATT_LOAD2(jj) do { _Pragma("unroll") for (int s2 = 0; s2 < 2; ++s2) { const int j_ = max((jj) - s2, 0); \
        const bf16_t* kp = P + (rowbase + 32 * j_ + srow) * PP + 64 * hh + 8 * sc8; kreg[s2] = *(const u32x4*)(kp + C_FK); vreg[s2] = *(const u32x4*)(P + (rowbase + 32 * j_ + vrow) * PP + C_FV + 64 * hh + 8 * vc8); \
        csreg[s2] = cum[32 * j_ + (gt & 31)]; } } while (0)
    ATT_LOAD2(jhi - 2 * g);
    const unsigned kmax_bits = KMAX[b * 8 + hh];
    const int jcand = 3 + tid; const float cum_blk = cum[BLK * qb], cum_cand = jcand < 4 * qb ? cum[32 * jcand + 31] : 0.f;
    { float qn = 0.f;
#pragma unroll
      for (int s = 0; s < 4; ++s)
#pragma unroll
          for (int j = 0; j < 8; ++j) { const float v = bf2f((unsigned short)qf[s][j]); qn += v * v; }
      qn += __shfl_xor(qn, 32);
#pragma unroll
      for (int o = 16; o > 0; o >>= 1) qn = fmaxf(qn, __shfl_xor(qn, o));
      if (lane == 0) misc[w] = qn;
      if (tid == 0) ((int*)misc)[8] = 3; }
    __syncthreads();
    { float qn = misc[0];
#pragma unroll
      for (int i = 1; i < 8; ++i) qn = fmaxf(qn, misc[i]);
      const float kmax = sqrtf(__uint_as_float(kmax_bits));
      const float thr = -(2.02f * sqrtf(qn) * kmax + PRUNE_T) * (1.0f / LOG2E);
      if (jcand < 4 * qb) { if (cum_blk - cum_cand < thr) atomicMax((int*)misc + 8, jcand + 1); } }
    __syncthreads();
    const int jlo = ((const int*)misc)[8];
    const int nchunk = (jhi - jlo + 2) >> 1, niter = (nchunk + 1) >> 1;
    float m = -INFINITY, lsum = 0.f; f32x16 o0, o1;
#pragma unroll
    for (int r = 0; r < 16; ++r) { o0[r] = 0.f; o1[r] = 0.f; }
#define ATT_STORE2(jj, bufsel) do { _Pragma("unroll") for (int s2 = 0; s2 < 2; ++s2) { const int j_ = (jj) - s2; if (j_ >= jlo) { unsigned char* bb = gl + (bufsel) * 20480 + s2 * 10240; bf16_t* Kl_ = (bf16_t*)bb; bf16_t* vt = (bf16_t*)(bb + 4608) + (8 * vc8) * 40 + vrow; \
        *(u32x4*)(Kl_ + srow * 72 + 8 * sc8) = kreg[s2]; \
        vt[0] = (bf16_t)vreg[s2].x; vt[40] = (bf16_t)(vreg[s2].x >> 16); vt[80] = (bf16_t)vreg[s2].y; vt[120] = (bf16_t)(vreg[s2].y >> 16); \
        vt[160] = (bf16_t)vreg[s2].z; vt[200] = (bf16_t)(vreg[s2].z >> 16); vt[240] = (bf16_t)vreg[s2].w; vt[280] = (bf16_t)(vreg[s2].w >> 16); \
        if (gt < 32) ((float*)(bb + 9728))[gt] = (32 * j_ + gt >= NPAD) ? csreg[s2] * LOG2E : INFINITY; } } } while (0)
    ATT_STORE2(jhi - 2 * g, 0); ATT_LOAD2(jhi - 2 * g - 4);
    __syncthreads();
    for (int it = 0; it < niter; ++it) {
        const int ja = jhi - 2 * g - 4 * it;
        ATT_STORE2(ja - 4, (it + 1) & 1);
        ATT_LOAD2(ja - 8);
#pragma unroll
        for (int s2 = 0; s2 < 2; ++s2) { const int j = ja - s2;
        if (j >= jlo && active && j <= 4 * qb + wq) {
            const unsigned char* bb = gl + (it & 1) * 20480 + s2 * 10240; const bf16_t* Kl = (const bf16_t*)bb; const bf16_t* Vt = (const bf16_t*)(bb + 4608); const float* csl = (const float*)(bb + 9728);
            f32x16 sacc;
#pragma unroll
            for (int g4 = 0; g4 < 4; ++g4) { const f32x4 c4 = *(const f32x4*)(csl + 8 * g4 + 4 * hi);
#pragma unroll
                for (int i = 0; i < 4; ++i) sacc[4 * g4 + i] = ct - c4[i]; }
#pragma unroll
            for (int s = 0; s < 4; ++s) { const bf16x8 kf = *(const bf16x8*)(Kl + l31 * 72 + 16 * s + 8 * hi); sacc = __builtin_amdgcn_mfma_f32_32x32x16_bf16(kf, qf[s], sacc, 0, 0, 0); }
            if (j == 4 * qb + wq) {
                asm volatile("" ::: "memory");
#pragma unroll
                for (int r = 0; r < 16; ++r) { const int kpos = 32 * j + 8 * (r >> 2) + 4 * hi + (r & 3); if (kpos > qp) sacc[r] = -INFINITY; } }
            float tmax = -INFINITY;
#pragma unroll
            for (int r = 0; r < 16; ++r) tmax = fmaxf(tmax, sacc[r]);
            tmax = fmaxf(tmax, __shfl_xor(tmax, 32));
            const float mnew = fmaxf(m, tmax), muse = mnew == -INFINITY ? 0.f : mnew;
            const float alpha = __builtin_amdgcn_exp2f(m - muse);
            m = mnew; lsum *= alpha;
#pragma unroll
            for (int r = 0; r < 16; ++r) { o0[r] *= alpha; o1[r] *= alpha; }
            float ps = 0.f;
#pragma unroll
            for (int r = 0; r < 16; ++r) { const float pv = __builtin_amdgcn_exp2f(sacc[r] - muse); sacc[r] = pv; ps += pv; }
            lsum += ps;
#pragma unroll
            for (int s = 0; s < 2; ++s) {
                u32x4 pw; pw.x = cvt_pk_bf16(sacc[8 * s + 0], sacc[8 * s + 1]); pw.y = cvt_pk_bf16(sacc[8 * s + 2], sacc[8 * s + 3]); pw.z = cvt_pk_bf16(sacc[8 * s + 4], sacc[8 * s + 5]); pw.w = cvt_pk_bf16(sacc[8 * s + 6], sacc[8 * s + 7]);
                const bf16x8 pf = __builtin_bit_cast(bf16x8, pw);
                { const bf16_t* vp = Vt + l31 * 40 + 16 * s + 4 * hi; const u32x2 lo = *(const u32x2*)vp, hi2 = *(const u32x2*)(vp + 8); u32x4 vv; vv.x = lo.x; vv.y = lo.y; vv.z = hi2.x; vv.w = hi2.y;
                  o0 = __builtin_amdgcn_mfma_f32_32x32x16_bf16(__builtin_bit_cast(bf16x8, vv), pf, o0, 0, 0, 0); }
                { const bf16_t* vp = Vt + (32 + l31) * 40 + 16 * s + 4 * hi; const u32x2 lo = *(const u32x2*)vp, hi2 = *(const u32x2*)(vp + 8); u32x4 vv; vv.x = lo.x; vv.y = lo.y; vv.z = hi2.x; vv.w = hi2.y;
                  o1 = __builtin_amdgcn_mfma_f32_32x32x16_bf16(__builtin_bit_cast(bf16x8, vv), pf, o1, 0, 0, 0); }
            }
        }
        }
        __syncthreads();
    }
#undef ATT_LOAD2
#undef ATT_STORE2
    lsum += __shfl_xor(lsum, 32);
    float* cb = comb + (size_t)(wq * 64 + lane) * 34;
    if (g == 1) { cb[0] = m; cb[1] = lsum;
#pragma unroll
        for (int r = 0; r < 16; ++r) { cb[2 + r] = o0[r]; cb[18 + r] = o1[r]; } }
    __syncthreads();
    if (g == 0 && qp >= NPAD && !dry) {
        const float m1 = cb[0], l1 = cb[1];
        const float mf = fmaxf(m, m1), a0 = __builtin_amdgcn_exp2f(m - mf), a1 = __builtin_amdgcn_exp2f(m1 - mf);
        const float inv = 1.0f / (lsum * a0 + l1 * a1);
        bf16_t* op = P + (rowbase + qp) * PP + C_FQ + 64 * hh + 4 * hi;
#pragma unroll
        for (int g4 = 0; g4 < 4; ++g4) {
            u32x2 w0, w1; float t0[4], t1[4];
#pragma unroll
            for (int i = 0; i < 4; ++i) { t0[i] = (o0[4 * g4 + i] * a0 + cb[2 + 4 * g4 + i] * a1) * inv; t1[i] = (o1[4 * g4 + i] * a0 + cb[18 + 4 * g4 + i] * a1) * inv; }
            w0.x = cvt_pk_bf16(t0[0], t0[1]); w0.y = cvt_pk_bf16(t0[2], t0[3]); w1.x = cvt_pk_bf16(t1[0], t1[1]); w1.y = cvt_pk_bf16(t1[2], t1[3]);
            *(u32x2*)(op + 8 * g4) = w0; *(u32x2*)(op + 32 + 8 * g4) = w1;
        }
    }
    __syncthreads();
}
__device__ __forceinline__ void attn_phase(bf16_t* P, const float* CUM, const unsigned* KMAX, unsigned char* lds, const bool dry) {
    const int c = blockIdx.x, G = gridDim.x;
    for (int rd = 0;; ++rd) {
        const int idx = (rd & 1) ? (rd + 1) * G - 1 - c : rd * G + c;
        if (rd * G >= 16 * NCH) break;
        if (idx >= 16 * NCH) continue;
        const int qb = NCH - 1 - idx / 16, bh = idx & 15;
        attn_unit(bh >> 3, bh & 7, qb, P, CUM, KMAX, lds, dry);
    }
}

constexpr int L_CB = 0, L_QT = 32768, L_KT = 51200, L_VT = 69632, L_ST = 104448, L_GAL = 122880;
static_assert(L_GAL + 8192 <= LDS_MAIN, "GLA LDS map");
__device__ __forceinline__ void gla_cb(int b, int hh, int c, const Args& ar, int layer, unsigned char* lds) {
    const int tid = otid(), k = tid & 63, seg = tid >> 6;
    float* CB = (float*)(lds + L_CB); float* SEG = (float*)(lds + L_QT); float* GAL = (float*)(lds + L_GAL);
    const float* GA = (const float*)(ar.ws + WS_GA);
    const size_t r0 = (size_t)b * LP + (size_t)BLK * c;
    *(f32x4*)(GAL + 4 * tid) = *(const f32x4*)(GA + r0 * 16 + 4 * tid);
    float wcol[16];
#pragma unroll
    for (int r = 0; r < 16; ++r) wcol[r] = ar.w_alpha_up[(size_t)layer * 16 * 256 + r * 256 + 64 * hh + k];
    const float bias = ar.b_alpha[layer * 256 + 64 * hh + k];
    __syncthreads();
    float vals[16]; float run = 0.f;
#pragma unroll
    for (int i = 0; i < 16; ++i) { const int t = 16 * seg + i; float x = bias;
#pragma unroll
        for (int r4 = 0; r4 < 4; ++r4) { const f32x4 gv = *(const f32x4*)(GAL + t * 16 + 4 * r4); x += gv[0] * wcol[4 * r4] + gv[1] * wcol[4 * r4 + 1] + gv[2] * wcol[4 * r4 + 2] + gv[3] * wcol[4 * r4 + 3]; }
        const float la = (BLK * c + t >= NPAD) ? logsigmoidf(x) * (1.0f / 16.0f) : 0.f;
        run += la; vals[i] = run; }
    SEG[seg * 64 + k] = run;
    __syncthreads();
    float off = 0.f;
#pragma unroll
    for (int s = 0; s < 8; ++s) off += (s < seg) ? SEG[s * 64 + k] : 0.f;
#pragma unroll
    for (int i = 0; i < 16; ++i) CB[(16 * seg + i) * 64 + k] = vals[i] + off;
    __syncthreads();
}
__device__ __forceinline__ void gla_load_v(u32x4 (&vr)[4], const bf16_t* P, size_t r0, int hh, int tid) {
#pragma unroll
    for (int i = 0; i < 4; ++i) { const int idx = tid + 512 * i, s = idx & 127, c16 = idx >> 7; vr[i] = *(const u32x4*)(P + (r0 + s) * PP + C_GV + 128 * hh + 8 * c16); }
}
__device__ __forceinline__ void gla_store_vt(const u32x4 (&vr)[4], unsigned char* lds, int tid) {
    bf16_t* VT = (bf16_t*)(lds + L_VT);
#pragma unroll
    for (int i = 0; i < 4; ++i) { const int idx = tid + 512 * i, s = idx & 127, c16 = idx >> 7; const u32x4 v = vr[i];
        bf16_t* vt = VT + (8 * c16) * 136 + s;
        vt[0] = (bf16_t)v.x; vt[136] = (bf16_t)(v.x >> 16); vt[272] = (bf16_t)v.y; vt[408] = (bf16_t)(v.y >> 16); vt[544] = (bf16_t)v.z; vt[680] = (bf16_t)(v.z >> 16); vt[816] = (bf16_t)v.w; vt[952] = (bf16_t)(v.w >> 16); }
}
__device__ __forceinline__ void gla_g1_unit(int b, int hh, int c, const Args& ar, int layer, unsigned char* lds) {
    const int tid = otid(), k = tid & 63, seg = tid >> 6, lane = tid & 63, w = tid >> 6, l15 = lane & 15, quad = lane >> 4;
    const bf16_t* P = (const bf16_t*)(ar.ws + WS_R2); float* STG = (float*)(ar.ws + WS_R1); float* DEC = (float*)(ar.ws + WS_DEC);
    const int unit = (b * 4 + hh) * NCH + c; const size_t r0 = (size_t)b * LP + (size_t)BLK * c;
    unsigned short kraw[16]; u32x4 vraw[4];
#pragma unroll
    for (int i = 0; i < 16; ++i) kraw[i] = P[(r0 + 16 * seg + i) * PP + C_GK + 64 * hh + k];
    gla_load_v(vraw, P, r0, hh, tid);
    gla_cb(b, hh, c, ar, layer, lds);
    const float* CB = (const float*)(lds + L_CB); bf16_t* KHT = (bf16_t*)(lds + L_KT); const bf16_t* VT = (const bf16_t*)(lds + L_VT);
    { const float cl = CB[127 * 64 + k]; unsigned pk[8];
#pragma unroll
      for (int i = 0; i < 16; i += 2) { const int t = 16 * seg + i;
          const float k0 = bf2f(kraw[i]) * __expf(cl - CB[t * 64 + k]);
          const float k1 = bf2f(kraw[i + 1]) * __expf(cl - CB[(t + 1) * 64 + k]);
          pk[i >> 1] = cvt_pk_bf16(k0, k1); }
      u32x4 w0, w1; w0.x = pk[0]; w0.y = pk[1]; w0.z = pk[2]; w0.w = pk[3]; w1.x = pk[4]; w1.y = pk[5]; w1.z = pk[6]; w1.w = pk[7];
      *(u32x4*)(KHT + k * 136 + 16 * seg) = w0; *(u32x4*)(KHT + k * 136 + 16 * seg + 8) = w1;
      if (seg == 0) DEC[unit * 64 + k] = __expf(cl); }
    gla_store_vt(vraw, lds, tid);
    __syncthreads();
#pragma unroll
    for (int kt = 0; kt < 4; ++kt) { f32x4 acc = {0.f, 0.f, 0.f, 0.f};
#pragma unroll
        for (int ks = 0; ks < 4; ++ks) { const bf16x8 af = *(const bf16x8*)(KHT + (16 * kt + l15) * 136 + 32 * ks + 8 * quad); const bf16x8 bfr = *(const bf16x8*)(VT + (16 * w + l15) * 136 + 32 * ks + 8 * quad);
            acc = __builtin_amdgcn_mfma_f32_16x16x32_bf16(af, bfr, acc, 0, 0, 0); }
        *(f32x4*)(STG + ((size_t)unit * 128 + 16 * w + l15) * 64 + 16 * kt + 4 * quad) = acc; }
    __syncthreads();
}
__device__ __forceinline__ void gla_g2_phase(const Args& ar) {
    float* STG = (float*)(ar.ws + WS_R1); const float* DEC = (const float*)(ar.ws + WS_DEC);
    const int gid = blockIdx.x * NTHREADS + otid();
    if (gid >= 8 * 8192) return;
    const int bh = gid >> 13, e = gid & 8191, k = e & 63;
    float carry = 0.f;
    float u[13], d[13], un[13], dn[13];
#pragma unroll
    for (int i = 0; i < 13; ++i) { const int unit = bh * NCH + i; u[i] = STG[(size_t)unit * 8192 + e]; d[i] = DEC[unit * 64 + k]; }
#pragma unroll 1
    for (int c0 = 0; c0 < NCH; c0 += 13) {
        if (c0 + 13 < NCH) {
#pragma unroll
            for (int i = 0; i < 13; ++i) { const int unit = bh * NCH + c0 + 13 + i; un[i] = STG[(size_t)unit * 8192 + e]; dn[i] = DEC[unit * 64 + k]; } }
#pragma unroll
        for (int i = 0; i < 13; ++i) { const int unit = bh * NCH + c0 + i; STG[(size_t)unit * 8192 + e] = carry; carry = d[i] * carry + u[i]; }
#pragma unroll
        for (int i = 0; i < 13; ++i) { u[i] = un[i]; d[i] = dn[i]; }
    }
}
__device__ __forceinline__ void gla_g3_unit(int b, int hh, int c, const Args& ar, int layer, unsigned char* lds, const bool dry) {
    const int tid = otid(), k = tid & 63, seg = tid >> 6, lane = tid & 63, w = tid >> 6, l15 = lane & 15, quad = lane >> 4;
    bf16_t* P = (bf16_t*)(ar.ws + WS_R2); const float* STG = (const float*)(ar.ws + WS_R1);
    const int unit = (b * 4 + hh) * NCH + c; const size_t r0 = (size_t)b * LP + (size_t)BLK * c;
    unsigned short qraw[16], kraw[16]; float sraw[16]; u32x4 vraw[4];
#pragma unroll
    for (int i = 0; i < 16; ++i) { const bf16_t* pp = P + (r0 + 16 * seg + i) * PP + 64 * hh + k; qraw[i] = pp[C_GQ]; kraw[i] = pp[C_GK]; }
#pragma unroll
    for (int i = 0; i < 16; ++i) sraw[i] = c == 0 ? 0.f : STG[((size_t)unit * 128 + seg + 8 * i) * 64 + k];
    gla_load_v(vraw, P, r0, hh, tid);
    u32x2 grraw[8];
    { const bf16_t* gp = P + (r0 + 16 * w + l15) * PP + C_GR + 128 * hh + 4 * quad;
#pragma unroll
      for (int vt = 0; vt < 8; ++vt) grraw[vt] = *(const u32x2*)(gp + 16 * vt); }
    gla_cb(b, hh, c, ar, layer, lds);
    const float* CB = (const float*)(lds + L_CB); bf16_t* QT = (bf16_t*)(lds + L_QT); bf16_t* KT = (bf16_t*)(lds + L_KT); const bf16_t* VT = (const bf16_t*)(lds + L_VT); bf16_t* ST = (bf16_t*)(lds + L_ST);
    const float ref = CB[63 * 64 + k];
    __syncthreads();
#pragma unroll
    for (int i = 0; i < 16; ++i) { const int t = 16 * seg + i; const float cbv = CB[t * 64 + k];
        const float qv = bf2f(qraw[i]) * __expf(cbv - ref);
        const float kv = bf2f(kraw[i]) * __expf(ref - cbv);
        QT[t * 72 + k] = (bf16_t)(cvt_pk_bf16(qv, 0.f)); KT[t * 72 + k] = (bf16_t)(cvt_pk_bf16(kv, 0.f)); }
    { const float er = __expf(ref);
#pragma unroll
      for (int i = 0; i < 16; ++i) { const int v = seg + 8 * i; ST[v * 72 + k] = (bf16_t)cvt_pk_bf16(sraw[i] * er, 0.f); } }
    gla_store_vt(vraw, lds, tid);
    __syncthreads();
    f32x4 acc[8];
#pragma unroll
    for (int vt = 0; vt < 8; ++vt) acc[vt] = (f32x4){0.f, 0.f, 0.f, 0.f};
    bf16x8 bq[2];
#pragma unroll
    for (int ks = 0; ks < 2; ++ks) bq[ks] = *(const bf16x8*)(QT + (16 * w + l15) * 72 + 32 * ks + 8 * quad);
#pragma unroll
    for (int ks = 0; ks < 2; ++ks)
#pragma unroll
        for (int vt = 0; vt < 8; ++vt) { const bf16x8 af = *(const bf16x8*)(ST + (16 * vt + l15) * 72 + 32 * ks + 8 * quad); acc[vt] = __builtin_amdgcn_mfma_f32_16x16x32_bf16(af, bq[ks], acc[vt], 0, 0, 0); }
    const int npairs = (w >> 1) + 1, tq = 16 * w + l15;
    for (int pr = 0; pr < npairs; ++pr) {
        f32x4 x0 = {0.f, 0.f, 0.f, 0.f}, x1 = x0;
#pragma unroll
        for (int ks = 0; ks < 2; ++ks) { const bf16x8 a0 = *(const bf16x8*)(KT + (32 * pr + l15) * 72 + 32 * ks + 8 * quad); const bf16x8 a1 = *(const bf16x8*)(KT + (32 * pr + 16 + l15) * 72 + 32 * ks + 8 * quad);
            x0 = __builtin_amdgcn_mfma_f32_16x16x32_bf16(a0, bq[ks], x0, 0, 0, 0); x1 = __builtin_amdgcn_mfma_f32_16x16x32_bf16(a1, bq[ks], x1, 0, 0, 0); }
#pragma unroll
        for (int j = 0; j < 4; ++j) { const int s0 = 32 * pr + 4 * quad + j; if (s0 > tq) x0[j] = 0.f; if (s0 + 16 > tq) x1[j] = 0.f; }
        u32x4 pw; pw.x = cvt_pk_bf16(x0[0], x0[1]); pw.y = cvt_pk_bf16(x0[2], x0[3]); pw.z = cvt_pk_bf16(x1[0], x1[1]); pw.w = cvt_pk_bf16(x1[2], x1[3]);
        const bf16x8 pf = __builtin_bit_cast(bf16x8, pw);
#pragma unroll
        for (int vt = 0; vt < 8; ++vt) { const bf16_t* vp = VT + (16 * vt + l15) * 136 + 32 * pr + 4 * quad; const u32x2 lo = *(const u32x2*)vp, hi2 = *(const u32x2*)(vp + 16);
            u32x4 vv; vv.x = lo.x; vv.y = lo.y; vv.z = hi2.x; vv.w = hi2.y;
            acc[vt] = __builtin_amdgcn_mfma_f32_16x16x32_bf16(__builtin_bit_cast(bf16x8, vv), pf, acc[vt], 0, 0, 0); }
    }
    float ss = 0.f;
#pragma unroll
    for (int vt = 0; vt < 8; ++vt) ss += acc[vt][0] * acc[vt][0] + acc[vt][1] * acc[vt][1] + acc[vt][2] * acc[vt][2] + acc[vt][3] * acc[vt][3];
    ss += __shfl_xor(ss, 16); ss += __shfl_xor(ss, 32);
    const float rs = rsqrtf(ss * (1.0f / 128.0f) + RMS_EPS);
    const float* gg = ar.g_gla_out + layer * 512 + 128 * hh;
    bf16_t* op = P + (r0 + tq) * PP + C_GR + 128 * hh + 4 * quad;
#pragma unroll
    for (int vt = 0; vt < 8; ++vt) { const u32x2 gr = grraw[vt]; const f32x4 g4 = *(const f32x4*)(gg + 16 * vt + 4 * quad);
        const float r0v = __uint_as_float(gr.x << 16), r1v = __uint_as_float(gr.x & 0xffff0000u), r2v = __uint_as_float(gr.y << 16), r3v = __uint_as_float(gr.y & 0xffff0000u);
        u32x2 wv; wv.x = cvt_pk_bf16(acc[vt][0] * rs * g4[0] * r0v, acc[vt][1] * rs * g4[1] * r1v); wv.y = cvt_pk_bf16(acc[vt][2] * rs * g4[2] * r2v, acc[vt][3] * rs * g4[3] * r3v);
        if (!dry) *(u32x2*)(op + 16 * vt) = wv; }
    __syncthreads();
}


constexpr int MAIN_ROWS = 64 * 256;
template <int EPI, int NS>
__device__ __forceinline__ void thin_gemm(const bf16_t* A, int lda, const bf16_t* Bt, int K, bf16_t* O, int ldc, bf16_t* P, unsigned char* lds) {
    const int tid = otid(), lane = tid & 63, w = tid >> 6, l31 = lane & 31, hi = lane >> 5;
    float* red = (float*)lds;
    for (int piece = blockIdx.x; piece < 256; piece += gridDim.x) {
        const int m0 = MAIN_ROWS + 32 * (piece >> 5), n0 = 32 * (piece & 31);
        const int kw = K >> 3, kb = w * kw;
        const bf16_t* ap = A + (size_t)(m0 + l31) * lda + kb + 8 * hi;
        const bf16_t* bp = Bt + (size_t)(n0 + l31) * K + kb + 8 * hi;
        f32x16 acc;
#pragma unroll
        for (int r = 0; r < 16; ++r) acc[r] = 0.f;
        bf16x8 wfr[NS], afr[NS];
#pragma unroll
        for (int s = 0; s < NS; ++s) { wfr[s] = *(const bf16x8*)(bp + 16 * s); afr[s] = *(const bf16x8*)(ap + 16 * s); }
#pragma unroll
        for (int s = 0; s < NS; ++s) acc = __builtin_amdgcn_mfma_f32_32x32x16_bf16(wfr[s], afr[s], acc, 0, 0, 0);
#pragma unroll
        for (int r = 0; r < 16; ++r) red[(w * 16 + r) * 64 + lane] = acc[r];
        __syncthreads();
        float v0 = 0.f, v1 = 0.f;
#pragma unroll
        for (int ww = 0; ww < 8; ++ww) { v0 += red[(ww * 16 + 2 * w) * 64 + lane]; v1 += red[(ww * 16 + 2 * w + 1) * 64 + lane]; }
        const int m = m0 + l31, n = n0 + ((2 * w) & 3) + 8 * ((2 * w) >> 2) + 4 * hi;
        if (EPI == 0) { *(unsigned*)(O + (size_t)m * ldc + n) = cvt_pk_bf16(v0, v1); }
        else { bf16_t* rowp = P + (size_t)m * PP + n; const unsigned gq = *(const unsigned*)(rowp + (EPI == 1 ? C_GTA : C_GTB));
            const float g0 = __uint_as_float(gq << 16), g1 = __uint_as_float(gq & 0xffff0000u);
            float t0 = 0.f, t1 = 0.f; if (EPI == 2) { const unsigned tq = *(const unsigned*)(rowp + C_YM); t0 = __uint_as_float(tq << 16); t1 = __uint_as_float(tq & 0xffff0000u); }
            *(unsigned*)(rowp + C_YM) = cvt_pk_bf16(t0 + v0 * g0, t1 + v1 * g1); }
        __syncthreads();
    }
}

#define XB_TMO      128
#define XB_XCNT(j)  (256  + 64 * (j))
#define XB_XSUB(j)  (1280 + 64 * (j))
#define XB_XGEN(j)  (2304 + 64 * (j))
#define XB_TOP      3328
#define XB_TOPGEN   3392
#define XCD_BAR_WORDS 3456
#define XB_SPIN_CAP (1u << 18)
#define LAS __attribute__((address_space(3)))

__device__ __forceinline__ unsigned xb_ld(unsigned* p)              { return __hip_atomic_load(p, __ATOMIC_RELAXED, __HIP_MEMORY_SCOPE_AGENT); }
__device__ __forceinline__ unsigned xb_add(unsigned* p, unsigned v) { return __hip_atomic_fetch_add(p, v, __ATOMIC_RELAXED, __HIP_MEMORY_SCOPE_AGENT); }
__device__ __forceinline__ unsigned xb_xcc_id() { return (unsigned)__builtin_amdgcn_s_getreg((3 << 11) | 20) & 0xFu; }
#define XB_SPIN(cond, bar) do { unsigned _sp = 0; while (cond) { __builtin_amdgcn_s_sleep(1); \
    if ((++_sp & 255u) == 0u) { if (xb_ld(&(bar)[XB_TMO])) break; if (_sp > XB_SPIN_CAP) { atomicAdd(&(bar)[XB_TMO], 1u); break; } } } } while (0)

struct XcdBarrier {
    unsigned* bar; unsigned x;
    volatile LAS unsigned* st;
};

__device__ unsigned g_bar[XCD_BAR_WORDS + 64];
__device__ __forceinline__ XcdBarrier xcd_barrier_post(unsigned* bar, volatile LAS unsigned* st) {
    XcdBarrier b; b.bar = bar; b.x = xb_xcc_id(); b.st = st;
    if (threadIdx.x == 0) (void)xb_add(&bar[XB_XCNT(b.x)], 1u);
    return b;
}
__device__ __forceinline__ void xcd_barrier_complete(unsigned* bar, unsigned x, unsigned& nloc, unsigned& nx) {
    const unsigned G = gridDim.x * gridDim.y * gridDim.z;
    unsigned sum, cnt, mine, sp = 0u;
    for (;;) {
        sum = 0u; cnt = 0u; mine = 0u;
#pragma unroll
        for (unsigned j = 0; j < 16; ++j) { const unsigned c = xb_ld(&bar[XB_XCNT(j)]); sum += c; cnt += (c > 0u) ? 1u : 0u; mine = (j == x) ? c : mine; }
        if (sum == G) break;
        __builtin_amdgcn_s_sleep(1);
        if ((++sp & 255u) == 0u) { if (xb_ld(&bar[XB_TMO])) break; if (sp > XB_SPIN_CAP) { atomicAdd(&bar[XB_TMO], 1u); break; } }
    }
    nloc = mine > 0u ? mine : 1u; nx = cnt > 0u ? cnt : 1u;
}

__device__ __forceinline__ void xcd_barrier(const XcdBarrier& b) {
    asm volatile("s_waitcnt vmcnt(0)" ::: "memory");
    __syncthreads();
    if (threadIdx.x == 0) {
        unsigned* bar = b.bar;
        __builtin_amdgcn_s_waitcnt(0);
        unsigned nloc = b.st[0], nx = b.st[1];
        if (nloc == 0u) { xcd_barrier_complete(bar, b.x, nloc, nx); b.st[0] = nloc; b.st[1] = nx; }
        const unsigned old = xb_add(&bar[XB_XSUB(b.x)], 1u);
        const unsigned gen = old / nloc;
        if (old + 1u == (gen + 1u) * nloc) {
            __builtin_amdgcn_fence(__ATOMIC_RELEASE, "agent");
            asm volatile("s_waitcnt vmcnt(0)" ::: "memory");
            const unsigned og = xb_add(&bar[XB_TOP], 1u);
            const unsigned tg = og / nx;
            if (og + 1u == (tg + 1u) * nx) xb_add(&bar[XB_TOPGEN], 1u);
            else XB_SPIN(xb_ld(&bar[XB_TOPGEN]) == tg, bar);
            __builtin_amdgcn_fence(__ATOMIC_ACQUIRE, "agent");
            xb_add(&bar[XB_XGEN(b.x)], 1u);
            asm volatile("s_waitcnt vmcnt(0)" ::: "memory");
        } else {
            XB_SPIN(xb_ld(&bar[XB_XGEN(b.x)]) == gen, bar);
            __builtin_amdgcn_fence(__ATOMIC_ACQUIRE, "agent");
            asm volatile("s_waitcnt vmcnt(0)" ::: "memory");
        }
    }
    __syncthreads();
}


__global__ void __launch_bounds__(NTHREADS, 2) fwd_megakernel(Args ar) {
    extern __shared__ __attribute__((aligned(16))) unsigned char lds[];
    cg::grid_group grid = cg::this_grid();
    if (gridDim.x == 0x7fffffffu) grid.sync();
    { const int t0_ = otid(); if (t0_ < 4) ((PG8_LAS unsigned*)(lds + LDS_MAIN))[t0_] = 0u; }
    __syncthreads();
    const XcdBarrier xbar = xcd_barrier_post(g_bar, (volatile LAS unsigned*)(PG8_LAS unsigned*)(lds + LDS_MAIN));
#ifdef PROBE_SYNC
#define GSYNC() do { xcd_barrier(xbar); xcd_barrier(xbar); } while (0)
#else
#define GSYNC() xcd_barrier(xbar)
#endif
    PG8_LAS unsigned char* lds3 = (PG8_LAS unsigned char*)lds;
    unsigned char* ws = ar.ws;
    bf16_t* R1 = (bf16_t*)(ws + WS_R1); bf16_t* R2 = (bf16_t*)(ws + WS_R2);
    float* LF = (float*)(ws + WS_LF); float* GA = (float*)(ws + WS_GA); float* CUM = (float*)(ws + WS_CUM); unsigned* KMAXW = (unsigned*)(ws + WS_KMAX);
    const int G = gridDim.x, cblk = blockIdx.x;

#pragma unroll 1
    for (int it = 0; it <= DEPTH; ++it) {
      const int layer = it - 1;
      if (layer >= 0) {
#pragma unroll 1
        for (int ffn = 0; ffn < 2; ++ffn) {
            if (ffn == 1) {
                { const int t0_ = otid(); if (cblk == 0 && t0_ < 16) KMAXW[t0_] = 0u; }
                { pg8::Gemm g{R1, (const bf16_t*)(ws + WS_WIN), MR, NINP, DM, DM}; pg8::StaticOrder S; S.init(MR, NINP, G, cblk);
                  pg8::EpiInProj E{R2, LF, GA, ar.b_f + layer * 8};
                  pg8::gemm_phase<pg8::EpiInProj, pg8::StaticOrder, true, true>(lds3, g, S, E); }
                GSYNC();
                cumsum_phase(LF, CUM, lds);
                kmax_phase(R2, KMAXW, lds);
                for (int u = cblk; u < 8 * 64; u += G) gla_g1_unit(u >> 8, (u >> 6) & 3, u & 63, ar, layer, lds);
#ifdef PROBE_G1
                for (int u = cblk; u < 8 * 64; u += G) gla_g1_unit(u >> 8, (u >> 6) & 3, u & 63, ar, layer, lds);
#endif
                GSYNC();
                gla_g2_phase(ar);
                if (G >= 136) { if (cblk >= 128 && cblk < 136) gla_g3_unit((cblk - 128) >> 2, (cblk - 128) & 3, 0, ar, layer, lds, false); }
                else if (cblk == 0) { for (int u = 0; u < 8; ++u) gla_g3_unit(u >> 2, u & 3, 0, ar, layer, lds, false); }
#ifdef PROBE_ATTN
                attn_phase(R2, CUM, KMAXW, lds, true);
#endif
                attn_phase(R2, CUM, KMAXW, lds, false);
                GSYNC();
#ifdef PROBE_G3
                for (int u = cblk; u < 8 * 64; u += G) gla_g3_unit(u >> 8, (u >> 6) & 3, 1 + (u & 63), ar, layer, lds, true);
#endif
                for (int u = cblk; u < 8 * 64; u += G) gla_g3_unit(u >> 8, (u >> 6) & 3, 1 + (u & 63), ar, layer, lds, false);
                { pg8::Gemm g{R2 + C_FQ, (const bf16_t*)(ws + WS_WFO), MAIN_ROWS, DM, 512, PP}; pg8::StaticOrder S; S.init(MAIN_ROWS, DM, G, cblk);
                  pg8::EpiMerge1 E{R2};
                  pg8::gemm_phase<pg8::EpiMerge1, pg8::StaticOrder, true, true>(lds3, g, S, E); }
                thin_gemm<1, 4>(R2 + C_FQ, PP, (const bf16_t*)(ws + WS_WFO), 512, nullptr, 0, R2, lds);
                GSYNC();
                { pg8::Gemm g{R2 + C_GR, (const bf16_t*)(ws + WS_WGO), MAIN_ROWS, DM, 512, PP}; pg8::StaticOrder S; S.init(MAIN_ROWS, DM, G, cblk);
                  pg8::EpiMerge2 E{R2};
                  pg8::gemm_phase<pg8::EpiMerge2, pg8::StaticOrder, true, true>(lds3, g, S, E); }
                thin_gemm<2, 4>(R2 + C_GR, PP, (const bf16_t*)(ws + WS_WGO), 512, nullptr, 0, R2, lds);
                GSYNC();
                { pg8::Gemm g{R2 + C_YM, (const bf16_t*)(ws + WS_WOUT), MAIN_ROWS, DM, DM, PP}; pg8::StaticOrder S; S.init(MAIN_ROWS, DM, G, cblk);
                  pg8::EpiPlain E{R1, DM};
                  pg8::gemm_phase<pg8::EpiPlain, pg8::StaticOrder, true, true>(lds3, g, S, E); }
                thin_gemm<0, 8>(R2 + C_YM, PP, (const bf16_t*)(ws + WS_WOUT), DM, R1, DM, nullptr, lds);
                GSYNC();
#ifdef PROBE_NORM
                norm_phase<1>(ar, R1, R1, 1.0f, ar.g_postm + layer * DM, ar.g_pre2 + layer * DM, true);
#endif
                norm_phase<1>(ar, R1, R1, 1.0f, ar.g_postm + layer * DM, ar.g_pre2 + layer * DM);
                GSYNC();
            }
            { pg8::Gemm g{R1, (const bf16_t*)(ws + (ffn ? WS_WGU2 : WS_WGU1)), MR, NGU, DM, DM}; pg8::StaticOrder S; S.init(MR, NGU, G, cblk);
              pg8::EpiSwiglu E{R2, DFF};
              pg8::gemm_phase<pg8::EpiSwiglu, pg8::StaticOrder, true, true>(lds3, g, S, E);
#ifdef PROBE_GU
              __syncthreads(); pg8::gemm_phase<pg8::EpiSwiglu, pg8::StaticOrder, true, true>(lds3, g, S, E);
#endif
            }
            GSYNC();
            { pg8::Gemm g{R2, (const bf16_t*)(ws + (ffn ? WS_WD2 : WS_WD1)), MAIN_ROWS, DM, DFF, DFF}; pg8::StaticOrder S; S.init(MAIN_ROWS, DM, G, cblk);
              pg8::EpiPlain E{R1, DM};
              pg8::gemm_phase<pg8::EpiPlain, pg8::StaticOrder, true, true>(lds3, g, S, E);
#ifdef PROBE_DOWN
              __syncthreads(); pg8::gemm_phase<pg8::EpiPlain, pg8::StaticOrder, true, true>(lds3, g, S, E);
#endif
            }
            thin_gemm<0, 22>(R2, DFF, (const bf16_t*)(ws + (ffn ? WS_WD2 : WS_WD1)), DFF, R1, DM, nullptr, lds);
#ifdef PROBE_THIN
            thin_gemm<0, 22>(R2, DFF, (const bf16_t*)(ws + (ffn ? WS_WD2 : WS_WD1)), DFF, R1, DM, nullptr, lds);
#endif
            GSYNC();
#ifdef PROBE_NORM
            norm_phase<1>(ar, R1, R1, 0.5f, ar.g_post1 + layer * DM, ar.g_prem + layer * DM, true);
#endif
            if (ffn == 0) norm_phase<1>(ar, R1, R1, 0.5f, ar.g_post1 + layer * DM, ar.g_prem + layer * DM);
            else norm_phase<1>(ar, R1, R1, 0.5f, ar.g_post2 + layer * DM, layer + 1 < DEPTH ? ar.g_pre1 + (layer + 1) * DM : nullptr);
            if (ffn == 0) GSYNC();
        }
      }
      if (it < DEPTH) convert_phase(ar, it, lds);
      if (it == 0) norm_phase<0>(ar, nullptr, R1, 0.f, nullptr, ar.g_pre1);
      if (it < DEPTH) GSYNC();
    }
    __syncthreads();
    { const int t = otid(); PG8_LAS unsigned* flag = (PG8_LAS unsigned*)(lds + LDS_MAIN) + 2;
      if (t == 0) { const unsigned old = __hip_atomic_fetch_add(&g_bar[XCD_BAR_WORDS], 1u, __ATOMIC_RELAXED, __HIP_MEMORY_SCOPE_AGENT); flag[0] = (old + 1u == gridDim.x) ? 1u : 0u; }
      __syncthreads();
      if (flag[0]) { for (int i = t; i < XCD_BAR_WORDS + 64; i += NTHREADS) __hip_atomic_store(&g_bar[i], 0u, __ATOMIC_RELAXED, __HIP_MEMORY_SCOPE_AGENT); } }
}

extern "C" void kernel_launch(void* const* d_in, const int* in_sizes, int n_in, void* d_out, int out_size, void* d_ws, size_t ws_size, hipStream_t stream) {
    static int grid = 0;
    if (grid == 0) {
        if (n_in != 20 || out_size != NB * SEQ * DM || ws_size < WS_END) { fprintf(stderr, "kernel_launch: unexpected shapes (n_in %d, out %d, ws %zu < %zu); nothing launched\n", n_in, out_size, ws_size, (size_t)WS_END); grid = -1; return; }
        int dev = 0, cus = 0, per_cu = 0;
        hipGetDevice(&dev); hipDeviceGetAttribute(&cus, hipDeviceAttributeMultiprocessorCount, dev);
        if (hipFuncSetAttribute((const void*)fwd_megakernel, hipFuncAttributeMaxDynamicSharedMemorySize, LDS_BYTES) != hipSuccess) { fprintf(stderr, "kernel_launch: hipFuncSetAttribute failed\n"); grid = -1; return; }
        if (hipOccupancyMaxActiveBlocksPerMultiprocessor(&per_cu, (const void*)fwd_megakernel, NTHREADS, LDS_BYTES) != hipSuccess || per_cu < 1) per_cu = 1;
        (void)hipGetLastError();
        grid = cus > 0 ? cus : 256;
    }
    if (grid < 0) return;
    Args a{};
    const float* const* in = (const float* const*)d_in;
    a.x = in[0]; a.meta = in[1]; a.w_in = in[2]; a.w_alpha_up = in[3]; a.b_alpha = in[4]; a.b_f = in[5]; a.g_gla_out = in[6]; a.w_fox_o = in[7]; a.w_gla_o = in[8]; a.w_out = in[9];
    a.w_gu1 = in[10]; a.w_d1 = in[11]; a.w_gu2 = in[12]; a.w_d2 = in[13]; a.g_pre1 = in[14]; a.g_post1 = in[15]; a.g_prem = in[16]; a.g_postm = in[17]; a.g_pre2 = in[18]; a.g_post2 = in[19];
    a.out = (float*)d_out; a.ws = (unsigned char*)d_ws;
    void* args[] = {&a};
    hipError_t e = hipLaunchCooperativeKernel((const void*)fwd_megakernel, dim3(grid), dim3(NTHREADS), args, LDS_BYTES, stream);
    if (e != hipSuccess) fprintf(stderr, "cooperative launch failed: %s (grid %d)\n", hipGetErrorString(e), grid);
}
```

```cpp
#include <hip/hip_runtime.h>
#include <hip/hip_cooperative_groups.h>
#include <cstdio>
#include <cstdint>
namespace cg = cooperative_groups;

constexpr int DM = 1024, NB = 2, SEQ = 8192, DEPTH = 2, NMETA = 16, BLK = 128, NPAD = 112;
constexpr int LP = SEQ + BLK;
constexpr int MR = NB * LP;
constexpr int DFF = 2816, NGU = 2 * DFF;
constexpr int NIN = 5144, NINP = 5376;
constexpr int PP = 5120;
constexpr int C_FQ = 0, C_FK = 512, C_FV = 1024, C_GQ = 1536, C_GK = 1792, C_GV = 2048, C_GR = 2560, C_GTA = 3072, C_GTB = 4096, C_YM = 512;
constexpr int NCH = LP / BLK;
constexpr float RMS_EPS = 1e-6f;
constexpr float LOG2E = 1.4426950408889634f;
constexpr float QSCALE = 0.125f * LOG2E;
namespace pg8 {
#define PG8_LAS __attribute__((address_space(3)))
typedef unsigned short bf16_t;
typedef short bf16x8 __attribute__((ext_vector_type(8)));
typedef float f32x4 __attribute__((ext_vector_type(4)));
typedef unsigned u32x4 __attribute__((ext_vector_type(4)));
constexpr int BM = 256, BK = 64, HALF = 128, HTB = HALF * BK * 2  , STAGE_BYTES = 8 * HTB, NXCD = 8, WGM = 4;

__host__ __device__ __forceinline__ int lds_byte(int r, int c) { const int st = (r >> 4) * 2 + (c >> 5), rr = r & 15, cc = c & 31, ob = rr * 64 + cc * 2; return st * 1024 + (ob ^ (((ob >> 9) & 1) << 5)); }
__host__ __device__ __forceinline__ void stage_rc(int b, int& R, int& C) { const int st = b / 1024, sb = b % 1024, swz = sb ^ (((sb >> 9) & 1) << 5); R = (st >> 1) * 16 + swz / 64; C = (st & 1) * 32 + (swz % 64) / 2; }
__host__ __device__ __forceinline__ int perm32(int rho) { const int n = rho >> 4, i = rho & 15; return 8 * (i >> 2) + 4 * n + (i & 3); }

struct Unit { int pm, pn; };
struct Gemm { const bf16_t* A; const bf16_t* Bt; int M, N, K, lda; };

struct StaticOrder {
    int nM, nN, nwg, G, c;
    __host__ __device__ void init(int M, int N, int G_, int c_) { nM = M / BM; nN = N / BM; nwg = nM * nN; G = G_; c = c_; }
    __host__ __device__ bool next(int i, Unit& u) const {
        const long L = (long)i * G + c; if (L >= nwg) return false;
        int wgid = (int)L; { const int q = nwg / NXCD, r = nwg % NXCD, xcd = wgid % NXCD, off = wgid / NXCD; wgid = (xcd < r ? xcd * (q + 1) : r * (q + 1) + (xcd - r) * q) + off; }
        const int nig = WGM * nN, gid = wgid / nig, fm = gid * WGM, gsz = (nM - fm) < WGM ? (nM - fm) : WGM;
        u.pm = fm + ((wgid % nig) % gsz); u.pn = (wgid % nig) / gsz; return true;
    }
    __device__ __forceinline__ void a_ready(const Unit&) const {}
    __device__ __forceinline__ void done(const Unit&) const {}
};

__device__ __forceinline__ unsigned cvt_pk_bf16(float lo, float hi) { unsigned r; asm volatile("v_cvt_pk_bf16_f32 %0, %1, %2" : "=v"(r) : "v"(lo), "v"(hi)); return r; }
typedef float f32x2 __attribute__((ext_vector_type(2)));
__device__ __forceinline__ float bf2f(unsigned short v) { return __uint_as_float(((unsigned)v) << 16); }
__device__ __forceinline__ float fsigmoid(float x) { return __builtin_amdgcn_rcpf(1.0f + __expf(-x)); }
__device__ __forceinline__ float fsilu(float x) { return x * fsigmoid(x); }
__device__ __forceinline__ float logsigmoidf(float x) { return fminf(x, 0.f) - __logf(1.0f + __expf(-fabsf(x))); }
__device__ __forceinline__ u32x4 pack8(const f32x4 v0, const f32x4 v1) { u32x4 w; w.x = cvt_pk_bf16(v0[0], v0[1]); w.y = cvt_pk_bf16(v0[2], v0[3]); w.z = cvt_pk_bf16(v1[0], v1[1]); w.w = cvt_pk_bf16(v1[2], v1[3]); return w; }
__device__ __forceinline__ void unpack8(const u32x4 w, f32x4& v0, f32x4& v1) {
    v0[0] = __uint_as_float(w.x << 16); v0[1] = __uint_as_float(w.x & 0xffff0000u); v0[2] = __uint_as_float(w.y << 16); v0[3] = __uint_as_float(w.y & 0xffff0000u);
    v1[0] = __uint_as_float(w.z << 16); v1[1] = __uint_as_float(w.z & 0xffff0000u); v1[2] = __uint_as_float(w.w << 16); v1[3] = __uint_as_float(w.w & 0xffff0000u); }

struct EpiPlain {
    static constexpr bool PERM = true, AFTER_DRAIN = false;
    bf16_t* O; int ldc;
    __device__ __forceinline__ void operator()(const f32x4 (&acc)[2][2][4][2], const Unit& u, int wr, int wc, int fr, int fq) const {
        const int row0 = u.pm * BM + wr * 64 + fr, col0 = u.pn * BM + wc * 32 + 8 * fq;
#pragma unroll
        for (int ai = 0; ai < 2; ++ai)
#pragma unroll
            for (int m = 0; m < 4; ++m) { bf16_t* rowp = O + (size_t)(row0 + ai * HALF + m * 16) * ldc + col0;
#pragma unroll
                for (int bj = 0; bj < 2; ++bj) *(u32x4*)(rowp + bj * HALF) = pack8(acc[ai][bj][m][0], acc[ai][bj][m][1]); }
    }
};
struct EpiSwiglu {
    static constexpr bool PERM = true, AFTER_DRAIN = false;
    bf16_t* O; int ldc;
    __device__ __forceinline__ void operator()(const f32x4 (&acc)[2][2][4][2], const Unit& u, int wr, int wc, int fr, int fq) const {
        const int row0 = u.pm * BM + wr * 64 + fr, col0 = u.pn * HALF + wc * 32 + 8 * fq;
#pragma unroll
        for (int ai = 0; ai < 2; ++ai)
#pragma unroll
            for (int m = 0; m < 4; ++m) { bf16_t* rowp = O + (size_t)(row0 + ai * HALF + m * 16) * ldc + col0;
                f32x4 o0, o1;
#pragma unroll
                for (int i = 0; i < 4; ++i) { o0[i] = fsilu(acc[ai][0][m][0][i]) * acc[ai][1][m][0][i]; o1[i] = fsilu(acc[ai][0][m][1][i]) * acc[ai][1][m][1][i]; }
                *(u32x4*)rowp = pack8(o0, o1); }
    }
};
struct EpiInProj {
    static constexpr bool PERM = true, AFTER_DRAIN = false;
    bf16_t* P; float* LF; float* GA; const float* b_f;
    __device__ __forceinline__ void operator()(const f32x4 (&acc)[2][2][4][2], const Unit& u, int wr, int wc, int fr, int fq) const {
        const int pn = u.pn; const int row0 = u.pm * BM + wr * 64 + fr;
        if (pn < 20) {
            const int mode = pn < 2 ? 1 : (pn == 6 ? 1 : (pn < 10 ? 0 : (pn < 12 ? 2 : 3)));
            const float sc = pn < 2 ? QSCALE : 0.125f;
            const int col0 = pn * BM + wc * 32 + 8 * fq;
#pragma unroll
            for (int ai = 0; ai < 2; ++ai)
#pragma unroll
                for (int m = 0; m < 4; ++m) { bf16_t* rowp = P + (size_t)(row0 + ai * HALF + m * 16) * PP + col0;
#pragma unroll
                    for (int bj = 0; bj < 2; ++bj) { f32x4 v0 = acc[ai][bj][m][0], v1 = acc[ai][bj][m][1];
                        if (mode == 1) { v0 = v0 * sc; v1 = v1 * sc; }
                        else if (mode == 2) {
#pragma unroll
                            for (int i = 0; i < 4; ++i) { v0[i] = fsilu(v0[i]); v1[i] = fsilu(v1[i]); } }
                        else if (mode == 3) {
#pragma unroll
                            for (int i = 0; i < 4; ++i) { v0[i] = fsigmoid(v0[i]); v1[i] = fsigmoid(v1[i]); } }
                        *(u32x4*)(rowp + bj * HALF) = pack8(v0, v1); } }
        } else if (wc == 0 && fq < 3) {
#pragma unroll
            for (int ai = 0; ai < 2; ++ai)
#pragma unroll
                for (int m = 0; m < 4; ++m) { const int r = row0 + ai * HALF + m * 16; const int p = r >= LP ? r - LP : r;
                    f32x4 v0 = acc[ai][0][m][0], v1 = acc[ai][0][m][1];
                    if (fq == 0) { const float valid = p >= NPAD ? 1.f : 0.f;
#pragma unroll
                        for (int i = 0; i < 4; ++i) { v0[i] = logsigmoidf(v0[i] + b_f[i]) * valid; v1[i] = logsigmoidf(v1[i] + b_f[4 + i]) * valid; }
                        *(f32x4*)(LF + (size_t)r * 8) = v0; *(f32x4*)(LF + (size_t)r * 8 + 4) = v1;
                    } else { float* g = GA + (size_t)r * 16 + 8 * (fq - 1); *(f32x4*)g = v0; *(f32x4*)(g + 4) = v1; } }
        }
    }
};
struct EpiMerge1 {
    static constexpr bool PERM = true, AFTER_DRAIN = false;
    bf16_t* P;
    __device__ __forceinline__ void operator()(const f32x4 (&acc)[2][2][4][2], const Unit& u, int wr, int wc, int fr, int fq) const {
        const int row0 = u.pm * BM + wr * 64 + fr, col0 = u.pn * BM + wc * 32 + 8 * fq;
#pragma unroll
        for (int ai = 0; ai < 2; ++ai)
#pragma unroll
            for (int m = 0; m < 4; ++m) { bf16_t* rowp = P + (size_t)(row0 + ai * HALF + m * 16) * PP + col0;
#pragma unroll
                for (int bj = 0; bj < 2; ++bj) { f32x4 g0, g1; unpack8(*(const u32x4*)(rowp + C_GTA + bj * HALF), g0, g1);
                    *(u32x4*)(rowp + C_YM + bj * HALF) = pack8(acc[ai][bj][m][0] * g0, acc[ai][bj][m][1] * g1); } }
    }
};
struct EpiMerge2 {
    static constexpr bool PERM = true, AFTER_DRAIN = false;
    bf16_t* P;
    __device__ __forceinline__ void operator()(const f32x4 (&acc)[2][2][4][2], const Unit& u, int wr, int wc, int fr, int fq) const {
        const int row0 = u.pm * BM + wr * 64 + fr, col0 = u.pn * BM + wc * 32 + 8 * fq;
#pragma unroll
        for (int ai = 0; ai < 2; ++ai)
#pragma unroll
            for (int m = 0; m < 4; ++m) { bf16_t* rowp = P + (size_t)(row0 + ai * HALF + m * 16) * PP + col0;
#pragma unroll
                for (int bj = 0; bj < 2; ++bj) { f32x4 g0, g1, t0, t1; unpack8(*(const u32x4*)(rowp + C_GTB + bj * HALF), g0, g1); unpack8(*(const u32x4*)(rowp + C_YM + bj * HALF), t0, t1);
                    *(u32x4*)(rowp + C_YM + bj * HALF) = pack8(t0 + acc[ai][bj][m][0] * g0, t1 + acc[ai][bj][m][1] * g1); } }
    }
};

template <class Epi, class Sched, bool ALIGN_EPI = false, bool SP2 = false>
__device__ __forceinline__ void gemm_phase(PG8_LAS unsigned char* lds, const Gemm g, const Sched& S, const Epi& E) {
    int tid_ = threadIdx.x; asm volatile("" : "+v"(tid_)); const int tid = tid_, wid = __builtin_amdgcn_readfirstlane(tid >> 6), lane = tid & 63, wr = wid >> 2, wc = wid & 3, fr = lane & 15, fq = lane >> 4;
    const int K = g.K, nt = K / BK;
    unsigned voffA[2], voffB[2];
#pragma unroll
    for (int i = 0; i < 2; ++i) { int R, C; stage_rc(tid * 16 + i * 8192, R, C); const int Rb = Epi::PERM ? ((R & ~31) + perm32(R & 31)) : R;
        voffA[i] = (unsigned)(R * g.lda + C) * 2u; voffB[i] = (unsigned)(Rb * K + C) * 2u; }
    const size_t kstep = (size_t)(BK * 2);
    const size_t hstep = (size_t)HALF * K * 2;
    const size_t tstep = 2 * hstep; const size_t hstepA = (size_t)HALF * g.lda * 2, tstepA = 2 * hstepA;
    const unsigned ldsw = (unsigned)wid * 1024u;
    const int aoff = lds_byte(wr * 64 + fr, fq * 8), boff = lds_byte(wc * 32 + fr, fq * 8);
#define PG8_SA(b, h) (((b) * 2 + (h)) * HTB)
#define PG8_SB(b, h) ((4 + (b) * 2 + (h)) * HTB)
#define PG8_STAGE(bufoff, gbase, voff) do { _Pragma("unroll") for (int _i = 0; _i < 2; ++_i) \
        __builtin_amdgcn_global_load_lds((const unsigned*)((const char*)(gbase) + (voff)[_i]), (PG8_LAS unsigned*)(lds + (bufoff) + ldsw + _i * 8192), 16, 0, 0); } while (0)
#define PG8_LDA(dst, b, h) do { _Pragma("unroll") for (int m = 0; m < 4; ++m) _Pragma("unroll") for (int k = 0; k < 2; ++k) dst[m][k] = *(const PG8_LAS bf16x8*)(lds + PG8_SA(b, h) + aoff + m * 2048 + k * 1024); } while (0)
#define PG8_LDB(dst, b, h) do { _Pragma("unroll") for (int n = 0; n < 2; ++n) _Pragma("unroll") for (int k = 0; k < 2; ++k) dst[n][k] = *(const PG8_LAS bf16x8*)(lds + PG8_SB(b, h) + boff + n * 2048 + k * 1024); } while (0)
#define PG8_MMA(ai, bj, At, Bt) do { __builtin_amdgcn_s_setprio(1); _Pragma("unroll") for (int m = 0; m < 4; ++m) _Pragma("unroll") for (int n = 0; n < 2; ++n) _Pragma("unroll") for (int k = 0; k < 2; ++k) \
        acc[ai][bj][m][n] = __builtin_amdgcn_mfma_f32_16x16x32_bf16(Bt[n][k], At[m][k], acc[ai][bj][m][n], 0, 0, 0); __builtin_amdgcn_s_setprio(0); } while (0)
#define PG8_WAIT_V(n) asm volatile("s_waitcnt vmcnt(" #n ")" ::: "memory")
#define PG8_WAIT_L(n) asm volatile("s_waitcnt lgkmcnt(" #n ")" ::: "memory")
#define PG8_BAR __builtin_amdgcn_s_barrier()
#define PG8_SCHED __builtin_amdgcn_sched_barrier(0)
    Unit cur, nxt; int ui = 0;
    if (!S.next(0, cur)) return;
    f32x4 acc[2][2][4][2];
#pragma unroll
    for (int a = 0; a < 2; ++a)
#pragma unroll
        for (int b = 0; b < 2; ++b)
#pragma unroll
            for (int m = 0; m < 4; ++m)
#pragma unroll
                for (int n = 0; n < 2; ++n) acc[a][b][m][n] = (f32x4){0.f, 0.f, 0.f, 0.f};
    bf16x8 At[4][2], B0[2][2], B1[2][2];
    const char* cA = (const char*)g.A + (size_t)cur.pm * tstepA; const char* cB = (const char*)g.Bt + (size_t)cur.pn * tstep;
    S.a_ready(cur);
    if constexpr (SP2) {
        PG8_STAGE(PG8_SB(0, 0), cB, voffB); PG8_STAGE(PG8_SB(0, 1), cB + hstep, voffB); PG8_STAGE(PG8_SA(0, 0), cA, voffA); PG8_STAGE(PG8_SA(0, 1), cA + hstepA, voffA);
        if (wr == 1) PG8_BAR;
        PG8_WAIT_V(2); PG8_BAR;
        PG8_STAGE(PG8_SB(1, 0), cB + kstep, voffB); PG8_STAGE(PG8_SA(1, 0), cA + kstep, voffA); PG8_STAGE(PG8_SB(1, 1), cB + hstep + kstep, voffB);
        PG8_WAIT_V(6); PG8_BAR;
    } else {
        PG8_STAGE(PG8_SB(0, 0), cB, voffB); PG8_STAGE(PG8_SA(0, 0), cA, voffA); PG8_STAGE(PG8_SB(0, 1), cB + hstep, voffB); PG8_STAGE(PG8_SA(0, 1), cA + hstepA, voffA);
        if (wr == 1) PG8_BAR;
        PG8_WAIT_V(4); PG8_BAR;
        PG8_STAGE(PG8_SB(1, 0), cB + kstep, voffB); PG8_STAGE(PG8_SA(1, 0), cA + kstep, voffA); PG8_STAGE(PG8_SB(1, 1), cB + hstep + kstep, voffB);
        PG8_WAIT_V(6); PG8_BAR;
    }
    for (;;) {
        const bool has_next = S.next(ui + 1, nxt);
        const char* nA = has_next ? (const char*)g.A + (size_t)nxt.pm * tstepA : cA; const char* nB = has_next ? (const char*)g.Bt + (size_t)nxt.pn * tstep : cB;
        for (int t = 0; t < nt; t += 2) {
            const bool last = (t == nt - 2);
            const char* a1 = cA + (size_t)(t + 1) * kstep;
            const char* a2 = last ? nA : cA + (size_t)(t + 2) * kstep; const char* b2 = last ? nB : cB + (size_t)(t + 2) * kstep;
            const char* a3 = a2 + kstep; const char* b3 = b2 + kstep;
            if (last && has_next) S.a_ready(nxt);
            if constexpr (SP2) {
            PG8_LDB(B0, 0, 0); PG8_LDB(B1, 0, 1); PG8_SCHED; PG8_LDA(At, 0, 0); PG8_STAGE(PG8_SA(1, 1), a1 + hstepA, voffA);
            PG8_WAIT_V(8); PG8_WAIT_L(0); PG8_BAR; PG8_MMA(0, 0, At, B0); PG8_MMA(0, 1, At, B1); PG8_BAR; PG8_SCHED;
            PG8_LDA(At, 0, 1); PG8_STAGE(PG8_SB(0, 0), b2, voffB); PG8_STAGE(PG8_SB(0, 1), b2 + hstep, voffB); PG8_STAGE(PG8_SA(0, 0), a2, voffA);
            PG8_WAIT_V(8); PG8_WAIT_L(0); PG8_BAR; PG8_MMA(1, 0, At, B0); PG8_MMA(1, 1, At, B1); PG8_BAR; PG8_SCHED;
            PG8_LDB(B0, 1, 0); PG8_LDB(B1, 1, 1); PG8_SCHED; PG8_LDA(At, 1, 0); PG8_STAGE(PG8_SA(0, 1), a2 + hstepA, voffA);
            PG8_WAIT_V(8); PG8_WAIT_L(0); PG8_BAR; PG8_MMA(0, 0, At, B0); PG8_MMA(0, 1, At, B1); PG8_BAR; PG8_SCHED;
            PG8_LDA(At, 1, 1); PG8_STAGE(PG8_SB(1, 0), b3, voffB); PG8_STAGE(PG8_SB(1, 1), b3 + hstep, voffB); PG8_STAGE(PG8_SA(1, 0), a3, voffA);
            PG8_WAIT_V(8); PG8_WAIT_L(0); PG8_BAR; PG8_MMA(1, 0, At, B0); PG8_MMA(1, 1, At, B1); PG8_BAR; PG8_SCHED;
            } else {
            PG8_LDB(B0, 0, 0); PG8_SCHED; PG8_LDA(At, 0, 0); PG8_STAGE(PG8_SA(1, 1), a1 + hstepA, voffA);
            PG8_WAIT_L(8); PG8_BAR; PG8_WAIT_L(0); PG8_MMA(0, 0, At, B0); PG8_BAR; PG8_SCHED;
            PG8_LDB(B1, 0, 1); PG8_STAGE(PG8_SB(0, 0), b2, voffB);
            PG8_BAR; PG8_WAIT_L(0); PG8_MMA(0, 1, At, B1); PG8_BAR;
            PG8_LDA(At, 0, 1); PG8_STAGE(PG8_SA(0, 0), a2, voffA);
            PG8_BAR; PG8_WAIT_L(0); PG8_MMA(1, 0, At, B0); PG8_BAR; PG8_SCHED;
            PG8_STAGE(PG8_SB(0, 1), b2 + hstep, voffB);
            PG8_WAIT_V(6); PG8_BAR; PG8_MMA(1, 1, At, B1); PG8_BAR;
            PG8_LDB(B0, 1, 0); PG8_SCHED; PG8_LDA(At, 1, 0); PG8_STAGE(PG8_SA(0, 1), a2 + hstepA, voffA);
            PG8_WAIT_L(8); PG8_BAR; PG8_WAIT_L(0); PG8_MMA(0, 0, At, B0); PG8_BAR; PG8_SCHED;
            PG8_LDB(B1, 1, 1); PG8_STAGE(PG8_SB(1, 0), b3, voffB);
            PG8_BAR; PG8_WAIT_L(0); PG8_MMA(0, 1, At, B1); PG8_BAR;
            PG8_LDA(At, 1, 1); PG8_STAGE(PG8_SA(1, 0), a3, voffA);
            PG8_BAR; PG8_WAIT_L(0); PG8_MMA(1, 0, At, B0); PG8_BAR; PG8_SCHED;
            PG8_STAGE(PG8_SB(1, 1), b3 + hstep, voffB);
            PG8_WAIT_V(6); PG8_BAR; PG8_MMA(1, 1, At, B1); PG8_BAR;
            }
        }
        if constexpr (ALIGN_EPI) { if (wr == 0) PG8_BAR; }
        if constexpr (!Epi::AFTER_DRAIN) { E(acc, cur, wr, wc, fr, fq); S.done(cur); }
        if (!has_next) break;
#pragma unroll
        for (int a = 0; a < 2; ++a)
#pragma unroll
            for (int b = 0; b < 2; ++b)
#pragma unroll
                for (int m = 0; m < 4; ++m)
#pragma unroll
                    for (int n = 0; n < 2; ++n) acc[a][b][m][n] = (f32x4){0.f, 0.f, 0.f, 0.f};
        cur = nxt; cA = nA; cB = nB; ++ui;
        if constexpr (ALIGN_EPI) { if (wr == 1) PG8_BAR; }
    }
    PG8_WAIT_V(0);
    if constexpr (!ALIGN_EPI) { if (wr == 0) PG8_BAR; }
    PG8_BAR;
    if constexpr (Epi::AFTER_DRAIN) { E.fused(acc, cur, wr, wc, fr, fq, lds, wid, lane); S.done(cur); }
#undef PG8_SA
#undef PG8_SB
#undef PG8_STAGE
#undef PG8_LDA
#undef PG8_LDB
#undef PG8_MMA
#undef PG8_WAIT_V
#undef PG8_WAIT_L
#undef PG8_BAR
#undef PG8_SCHED
}
}

typedef unsigned short bf16_t;
typedef short bf16x8 __attribute__((ext_vector_type(8)));
typedef short s16x4 __attribute__((ext_vector_type(4)));
typedef float f32x4 __attribute__((ext_vector_type(4)));
typedef float f32x16 __attribute__((ext_vector_type(16)));
typedef unsigned u32x4 __attribute__((ext_vector_type(4)));
typedef unsigned u32x2 __attribute__((ext_vector_type(2)));
using pg8::bf2f; using pg8::cvt_pk_bf16; using pg8::fsigmoid; using pg8::logsigmoidf;

constexpr int NTHREADS = 512, NWAVES = 8;
constexpr int LDS_MAIN = 131072;
constexpr int LDS_BYTES = LDS_MAIN + 256;

constexpr size_t SZ_WGU = (size_t)NGU * DM * 2, SZ_WD = (size_t)DM * DFF * 2, SZ_WIN = (size_t)NINP * DM * 2, SZ_WO5 = (size_t)DM * 512 * 2, SZ_WOUT = (size_t)DM * DM * 2;
constexpr size_t WS_WGU1 = 0, WS_WD1 = WS_WGU1 + SZ_WGU, WS_WIN = WS_WD1 + SZ_WD, WS_WFO = WS_WIN + SZ_WIN, WS_WGO = WS_WFO + SZ_WO5, WS_WOUT = WS_WGO + SZ_WO5,
                 WS_WGU2 = WS_WOUT + SZ_WOUT, WS_WD2 = WS_WGU2 + SZ_WGU, WS_HM = WS_WD2 + SZ_WD;
constexpr size_t WS_LF = WS_HM + (size_t)NB * BLK * DM * 4;
constexpr size_t WS_GA = WS_LF + (size_t)MR * 8 * 4;
constexpr size_t WS_CUM = WS_GA + (size_t)MR * 16 * 4;
constexpr size_t WS_DEC = WS_CUM + (size_t)16 * LP * 4;
constexpr size_t WS_KMAX = WS_DEC + (size_t)8 * NCH * 64 * 4;
constexpr size_t WS_BAR = WS_KMAX + 256;
constexpr size_t WS_R1 = WS_BAR + 16384;
constexpr size_t WS_R2 = WS_R1 + (size_t)MR * DM * 2;
constexpr size_t WS_END = WS_R2 + (size_t)MR * PP * 2;
static_assert(WS_END <= (size_t)256 * 1024 * 1024, "workspace map exceeds 256 MiB");
static_assert((size_t)8 * NCH * 128 * 64 * 4 <= (size_t)MR * DM * 2, "GLA states must fit region R1");

struct Args {
    const float* x; const float* meta; const float* w_in; const float* w_alpha_up; const float* b_alpha; const float* b_f; const float* g_gla_out;
    const float* w_fox_o; const float* w_gla_o; const float* w_out; const float* w_gu1; const float* w_d1; const float* w_gu2; const float* w_d2;
    const float* g_pre1; const float* g_post1; const float* g_prem; const float* g_postm; const float* g_pre2; const float* g_post2;
    float* out; unsigned char* ws;
};

__device__ __forceinline__ float* hrow(float* out, float* hm, int r) {
    const int b = r >= LP ? 1 : 0, p = r - b * LP;
    return p < BLK ? hm + (size_t)(b * BLK + p) * DM : out + ((size_t)b * SEQ + (p - BLK)) * DM;
}
__device__ __forceinline__ int otid() { int t = threadIdx.x; asm volatile("" : "+v"(t)); return t; }
#define LDS_BARRIER() asm volatile("s_waitcnt lgkmcnt(0)\n\ts_barrier" ::: "memory")
__device__ __forceinline__ float wave_sum(float v) {
#pragma unroll
    for (int o = 32; o > 0; o >>= 1) v += __shfl_xor(v, o);
    return v;
}

__device__ __forceinline__ int src_col(int kind, int n) {
    if (kind == 0) return n;
    if (kind == 1) { const int t = n >> 8, w = n & 255; return (w >> 7) * DFF + 128 * t + (w & 127); }
    if (n < 1536) return n;
    if (n < 2560) return n + 8;
    if (n < 5120) return n + 24;
    if (n < 5128) return n - 5120 + 1536;
    if (n < 5144) return n - 5128 + 2568;
    return -1;
}
constexpr int CT0 = 1408, CT1 = CT0 + 704, CT2 = CT1 + 1344, CT3 = CT2 + 128, CT4 = CT3 + 128, CT5 = CT4 + 256, CT6 = CT5 + 1408, CT7 = CT6 + 704;
__device__ __forceinline__ void conv_setup(const Args& ar, int layer, int t, int tid, const float*& lp, bool& ok, bf16_t*& sp) {
    unsigned char* ws = ar.ws;
    const float* src; bf16_t* dst; int K, ldsrc, kind, tt;
    if (t < CT0)      { src = ar.w_gu1 + (size_t)layer * DM * NGU;   dst = (bf16_t*)(ws + WS_WGU1); K = DM;  ldsrc = NGU; kind = 1; tt = t; }
    else if (t < CT1) { src = ar.w_d1 + (size_t)layer * DFF * DM;    dst = (bf16_t*)(ws + WS_WD1);  K = DFF; ldsrc = DM;  kind = 0; tt = t - CT0; }
    else if (t < CT2) { src = ar.w_in + (size_t)layer * DM * NIN;    dst = (bf16_t*)(ws + WS_WIN);  K = DM;  ldsrc = NIN; kind = 2; tt = t - CT1; }
    else if (t < CT3) { src = ar.w_fox_o + (size_t)layer * 512 * DM; dst = (bf16_t*)(ws + WS_WFO);  K = 512; ldsrc = DM;  kind = 0; tt = t - CT2; }
    else if (t < CT4) { src = ar.w_gla_o + (size_t)layer * 512 * DM; dst = (bf16_t*)(ws + WS_WGO);  K = 512; ldsrc = DM;  kind = 0; tt = t - CT3; }
    else if (t < CT5) { src = ar.w_out + (size_t)layer * DM * DM;    dst = (bf16_t*)(ws + WS_WOUT); K = DM;  ldsrc = DM;  kind = 0; tt = t - CT4; }
    else if (t < CT6) { src = ar.w_gu2 + (size_t)layer * DM * NGU;   dst = (bf16_t*)(ws + WS_WGU2); K = DM;  ldsrc = NGU; kind = 1; tt = t - CT5; }
    else              { src = ar.w_d2 + (size_t)layer * DFF * DM;    dst = (bf16_t*)(ws + WS_WD2);  K = DFF; ldsrc = DM;  kind = 0; tt = t - CT6; }
    const int nk = K >> 6, n0 = (tt / nk) << 6, k0 = (tt % nk) << 6;
    const int sc = src_col(kind, n0 + 8 * (tid & 7));
    ok = sc >= 0; lp = src + (size_t)(k0 + (tid >> 3)) * ldsrc + (ok ? sc : 0);
    sp = dst + (size_t)(n0 + (tid >> 3)) * K + k0 + 8 * (tid & 7);
}
__device__ __forceinline__ void convert_phase(const Args& ar, int layer, unsigned char* lds) {
    const int tid = otid(); const int kl = tid >> 3, c8 = tid & 7;
    const float* lp; bool ok; bf16_t* sp; f32x4 v0 = {0.f, 0.f, 0.f, 0.f}, v1 = v0;
    int t = blockIdx.x, buf = 0;
    if (t < CT7) { conv_setup(ar, layer, t, tid, lp, ok, sp); if (ok) { v0 = *(const f32x4*)lp; v1 = *(const f32x4*)(lp + 4); } else { v0 = (f32x4){0.f, 0.f, 0.f, 0.f}; v1 = v0; } }
#pragma unroll 1
    for (; t < CT7; t += gridDim.x) {
        bf16_t* T = (bf16_t*)(lds + buf * 9216);
        { const unsigned a = cvt_pk_bf16(v0[0], v0[1]), b = cvt_pk_bf16(v0[2], v0[3]), cc = cvt_pk_bf16(v1[0], v1[1]), d = cvt_pk_bf16(v1[2], v1[3]);
          bf16_t* q = T + (8 * c8) * 72 + (kl ^ (8 * c8));
          q[0] = (bf16_t)a; q[72] = (bf16_t)(a >> 16); q[144] = (bf16_t)b; q[216] = (bf16_t)(b >> 16); q[288] = (bf16_t)cc; q[360] = (bf16_t)(cc >> 16); q[432] = (bf16_t)d; q[504] = (bf16_t)(d >> 16); }
        __syncthreads();
        bf16_t* spc = sp;
        const int tn = t + gridDim.x;
        if (tn < CT7) { conv_setup(ar, layer, tn, tid, lp, ok, sp); if (ok) { v0 = *(const f32x4*)lp; v1 = *(const f32x4*)(lp + 4); } else { v0 = (f32x4){0.f, 0.f, 0.f, 0.f}; v1 = v0; } }
        *(u32x4*)spc = *(const u32x4*)(T + kl * 72 + ((8 * c8) ^ (8 * ((kl >> 3) & 7))));
        buf ^= 1;
    }
    __syncthreads();
}

template <int MODE>
__device__ __forceinline__ void norm_phase(const Args& ar, const bf16_t* y, bf16_t* a, float coef, const float* gpost, const float* gpre, const bool dry = false) {
    float* hm = (float*)(ar.ws + WS_HM);
    const int tid = otid(); const int lane = tid & 63, wv = tid >> 6;
    const int stride = gridDim.x * NWAVES;
    for (int r0 = blockIdx.x * NWAVES + wv; r0 < MR; r0 += 2 * stride) {
        const bool has1 = r0 + stride < MR; const int rr[2] = {r0, has1 ? r0 + stride : r0};
        f32x4 h[2][4], v[2][4]; float* hp[2];
#pragma unroll
        for (int q = 0; q < 2; ++q) { const int r = rr[q]; hp[q] = hrow(ar.out, hm, r); const int b = r >= LP ? 1 : 0, p = r - b * LP;
            if (MODE == 0) {
#pragma unroll
                for (int i = 0; i < 4; ++i) { const int c = 256 * i + 4 * lane;
                    if (p < NPAD) h[q][i] = (f32x4){0.f, 0.f, 0.f, 0.f};
                    else if (p < BLK) h[q][i] = *(const f32x4*)(ar.meta + (size_t)(p - NPAD) * DM + c);
                    else h[q][i] = *(const f32x4*)(ar.x + ((size_t)b * SEQ + (p - BLK)) * DM + c); }
            } else {
#pragma unroll
                for (int i = 0; i < 4; ++i) { const int c = 256 * i + 4 * lane; const u32x2 w = __builtin_nontemporal_load((const u32x2*)(y + (size_t)r * DM + c));
                    v[q][i][0] = __uint_as_float(w.x << 16); v[q][i][1] = __uint_as_float(w.x & 0xffff0000u); v[q][i][2] = __uint_as_float(w.y << 16); v[q][i][3] = __uint_as_float(w.y & 0xffff0000u);
                    h[q][i] = __builtin_nontemporal_load((const f32x4*)(hp[q] + c)); }
            } }
#pragma unroll
        for (int q = 0; q < 2; ++q) { if (q == 1 && !has1) break; const int r = rr[q];
            if (MODE == 1) { float ss = 0.f;
#pragma unroll
                for (int i = 0; i < 4; ++i) ss += v[q][i][0] * v[q][i][0] + v[q][i][1] * v[q][i][1] + v[q][i][2] * v[q][i][2] + v[q][i][3] * v[q][i][3];
                ss = wave_sum(ss); const float rs = coef * rsqrtf(ss * (1.0f / DM) + RMS_EPS);
#pragma unroll
                for (int i = 0; i < 4; ++i) { const int c = 256 * i + 4 * lane; const f32x4 g = *(const f32x4*)(gpost + c); h[q][i] = h[q][i] + v[q][i] * g * rs; } }
#pragma unroll
            for (int i = 0; i < 4; ++i) if (!dry) __builtin_nontemporal_store(h[q][i], (f32x4*)(hp[q] + 256 * i + 4 * lane));
            if (gpre) { float ss = 0.f;
#pragma unroll
                for (int i = 0; i < 4; ++i) ss += h[q][i][0] * h[q][i][0] + h[q][i][1] * h[q][i][1] + h[q][i][2] * h[q][i][2] + h[q][i][3] * h[q][i][3];
                ss = wave_sum(ss); const float rs = rsqrtf(ss * (1.0f / DM) + RMS_EPS);
#pragma unroll
                for (int i = 0; i < 4; ++i) { const int c = 256 * i + 4 * lane; const f32x4 g = *(const f32x4*)(gpre + c); const f32x4 o = h[q][i] * g * rs;
                    u32x2 w; w.x = cvt_pk_bf16(o[0], o[1]); w.y = cvt_pk_bf16(o[2], o[3]); if (!dry) *(u32x2*)(a + (size_t)r * DM + c) = w; } }
        }
    }
}

__device__ __forceinline__ void cumsum_phase(const float* LF, float* CUM, unsigned char* lds) {
    if (blockIdx.x >= 16) return;
    const int tid = otid(), lane = tid & 63, wv = tid >> 6, seq = blockIdx.x, b = seq >> 3, hh = seq & 7, p0 = 17 * tid;
    float* wt = (float*)lds;
    float v[17]; float s = 0.f;
#pragma unroll
    for (int i = 0; i < 17; ++i) { const int p = p0 + i; const float x = p < LP ? LF[(size_t)(b * LP + p) * 8 + hh] : 0.f; s += x; v[i] = s; }
    float sc = s;
#pragma unroll
    for (int o = 1; o < 64; o <<= 1) { const float t = __shfl_up(sc, o); if (lane >= o) sc += t; }
    if (lane == 63) wt[wv] = sc;
    __syncthreads();
    float off = sc - s;
#pragma unroll
    for (int w2 = 0; w2 < 8; ++w2) off += (w2 < wv) ? wt[w2] : 0.f;
#pragma unroll
    for (int i = 0; i < 17; ++i) { const int p = p0 + i; if (p < LP) CUM[(size_t)seq * LP + p] = v[i] + off; }
    __syncthreads();
}

constexpr float PRUNE_T = 40.0f;
__device__ __forceinline__ void kmax_phase(const bf16_t* P, unsigned* KMAX, unsigned char* lds) {
    const int tid = otid(), lane = tid & 63, wv = tid >> 6; float mx0 = 0.f, mx1 = 0.f;
    const int stride = gridDim.x * NWAVES;
    for (int rb = blockIdx.x * NWAVES + wv; rb < MR; rb += 9 * stride) {
        u32x4 kv9[9];
#pragma unroll
        for (int q = 0; q < 9; ++q) { const int r = rb + q * stride; kv9[q] = r < MR ? *(const u32x4*)(P + (size_t)r * PP + C_FK + 8 * lane) : (u32x4){0u, 0u, 0u, 0u}; }
#pragma unroll
        for (int q = 0; q < 9; ++q) { const int r = rb + q * stride; const u32x4 kv = kv9[q];
            const float a0 = __uint_as_float(kv.x << 16), a1 = __uint_as_float(kv.x & 0xffff0000u), a2 = __uint_as_float(kv.y << 16), a3 = __uint_as_float(kv.y & 0xffff0000u),
                        a4 = __uint_as_float(kv.z << 16), a5 = __uint_as_float(kv.z & 0xffff0000u), a6 = __uint_as_float(kv.w << 16), a7 = __uint_as_float(kv.w & 0xffff0000u);
            float ss = a0 * a0 + a1 * a1 + a2 * a2 + a3 * a3 + a4 * a4 + a5 * a5 + a6 * a6 + a7 * a7;
            ss += __shfl_xor(ss, 1); ss += __shfl_xor(ss, 2); ss += __shfl_xor(ss, 4);
            if (r >= LP) mx1 = fmaxf(mx1, ss); else mx0 = fmaxf(mx0, ss); }
    }
    float* red = (float*)lds;
    if ((lane & 7) == 0) { red[(lane >> 3) * 8 + wv] = mx0; red[64 + (lane >> 3) * 8 + wv] = mx1; }
    __syncthreads();
    if (tid < 16) { float m = 0.f;
#pragma unroll
        for (int i = 0; i < 8; ++i) m = fmaxf(m, red[tid * 8 + i]);
        atomicMax(KMAX + tid, __float_as_uint(m)); }
    __syncthreads();
}
__device__ __forceinline__ void attn_unit(int b, int hh, int qb, bf16_t* P, const float* CUM, const unsigned* KMAX, unsigned char* lds, const bool dry) {
    const int tid = otid(), lane = tid & 63, w = tid >> 6, g = w >> 2, wq = w & 3, l31 = lane & 31, hi = lane >> 5, gt = tid & 255;
    const size_t rowbase = (size_t)b * LP;
    const int qp = BLK * qb + 32 * wq + l31;
    const float* cum = CUM + (size_t)(b * 8 + hh) * LP;
    unsigned char* gl = lds + g * 40960;
    float* comb = (float*)(lds + 81920);
    float* misc = (float*)(lds + 116736);
    const bool active = (BLK * qb + 32 * wq + 31) >= NPAD;
    bf16x8 qf[4];
    { const bf16_t* qptr = P + (rowbase + qp) * PP + C_FQ + 64 * hh + 8 * hi;
#pragma unroll
      for (int s = 0; s < 4; ++s) qf[s] = *(const bf16x8*)(qptr + 16 * s); }
    const float ct = cum[qp] * LOG2E;
    const int jhi = 4 * qb + 3;
    const int srow = gt >> 3, sc8 = gt & 7;
    u32x4 kreg[4], vreg[4]; float csreg[4];
    const int vrow = gt & 31, vc8 = gt >> 5;
#define ATT_LOAD4(sc) do { _Pragma("unroll") for (int i4 = 0; i4 < 4; ++i4) { const int j_ = max(jhi - 8 * (sc) - 2 * i4 - g, 0); \
        const bf16_t* kp = P + (rowbase + 32 * j_ + srow) * PP + 64 * hh + 8 * sc8; kreg[i4] = *(const u32x4*)(kp + C_FK); vreg[i4] = *(const u32x4*)(P + (rowbase + 32 * j_ + vrow) * PP + C_FV + 64 * hh + 8 * vc8); \
        csreg[i4] = cum[32 * j_ + (gt & 31)]; } } while (0)
    ATT_LOAD4(0);
    const unsigned kmax_bits = KMAX[b * 8 + hh];
    const int jcand = 3 + tid; const float cum_blk = cum[BLK * qb], cum_cand = jcand < 4 * qb ? cum[32 * jcand + 31] : 0.f;
    { float qn = 0.f;
#pragma unroll
      for (int s = 0; s < 4; ++s)
#pragma unroll
          for (int j = 0; j < 8; ++j) { const float v = bf2f((unsigned short)qf[s][j]); qn += v * v; }
      qn += __shfl_xor(qn, 32);
#pragma unroll
      for (int o = 16; o > 0; o >>= 1) qn = fmaxf(qn, __shfl_xor(qn, o));
      if (lane == 0) misc[w] = qn;
      if (tid == 0) ((int*)misc)[8] = 3; }
    LDS_BARRIER();
    { float qn = misc[0];
#pragma unroll
      for (int i = 1; i < 8; ++i) qn = fmaxf(qn, misc[i]);
      const float kmax = sqrtf(__uint_as_float(kmax_bits));
      const float thr = -(2.02f * sqrtf(qn) * kmax + PRUNE_T) * (1.0f / LOG2E);
      const bool neg = jcand < 4 * qb && (cum_blk - cum_cand < thr);
      const unsigned long long bal = __ballot(neg);
      if (bal != 0ull && lane == 0) atomicMax((int*)misc + 8, 3 + 64 * w + (63 - __clzll((long long)bal)) + 1); }
    LDS_BARRIER();
    const int jlo = ((const int*)misc)[8];
#ifdef PROBE_ATTN_NOLOOP
    const int nsc = dry ? 0 : (jhi - jlo + 8) >> 3;
#else
    const int nsc = (jhi - jlo + 8) >> 3;
#endif
    float m = -INFINITY, lsum = 0.f; f32x16 o0, o1;
#pragma unroll
    for (int r = 0; r < 16; ++r) { o0[r] = 0.f; o1[r] = 0.f; }
#define ATT_STORE4(sc) do { _Pragma("unroll") for (int i4 = 0; i4 < 4; ++i4) { const int j_ = jhi - 8 * (sc) - 2 * i4 - g; if (j_ >= jlo) { unsigned char* bb = gl + i4 * 10240; bf16_t* Kl_ = (bf16_t*)bb; bf16_t* vt = (bf16_t*)(bb + 4608) + (8 * vc8) * 40 + vrow; \
        *(u32x4*)(Kl_ + srow * 72 + 8 * sc8) = kreg[i4]; \
        vt[0] = (bf16_t)vreg[i4].x; vt[40] = (bf16_t)(vreg[i4].x >> 16); vt[80] = (bf16_t)vreg[i4].y; vt[120] = (bf16_t)(vreg[i4].y >> 16); \
        vt[160] = (bf16_t)vreg[i4].z; vt[200] = (bf16_t)(vreg[i4].z >> 16); vt[240] = (bf16_t)vreg[i4].w; vt[280] = (bf16_t)(vreg[i4].w >> 16); \
        if (gt < 32) ((float*)(bb + 9728))[gt] = (32 * j_ + gt >= NPAD) ? csreg[i4] * LOG2E : INFINITY; } } } while (0)
    for (int sc = 0; sc < nsc; ++sc) {
        ATT_STORE4(sc);
        if (sc + 1 < nsc) ATT_LOAD4(sc + 1);
        LDS_BARRIER();
#pragma unroll
        for (int pp = 0; pp < 2; ++pp) {
            const int jA = jhi - 8 * sc - 4 * pp - g, jB = jA - 2;
            const bool vA = jA >= jlo && active && jA <= 4 * qb + wq, vB = jB >= jlo && active && jB <= 4 * qb + wq;
            if (vA || vB) {
                const unsigned char* bA = gl + (2 * pp) * 10240; const unsigned char* bB = gl + (2 * pp + 1) * 10240;
                f32x16 sA, sB;
#pragma unroll
                for (int r = 0; r < 16; ++r) { sA[r] = -INFINITY; sB[r] = -INFINITY; }
                if (vA) { const float* csl = (const float*)(bA + 9728);
#pragma unroll
                    for (int g4 = 0; g4 < 4; ++g4) { const f32x4 c4 = *(const f32x4*)(csl + 8 * g4 + 4 * hi);
#pragma unroll
                        for (int i = 0; i < 4; ++i) sA[4 * g4 + i] = ct - c4[i]; } }
                if (vB) { const float* csl = (const float*)(bB + 9728);
#pragma unroll
                    for (int g4 = 0; g4 < 4; ++g4) { const f32x4 c4 = *(const f32x4*)(csl + 8 * g4 + 4 * hi);
#pragma unroll
                        for (int i = 0; i < 4; ++i) sB[4 * g4 + i] = ct - c4[i]; } }
                if (vA) {
#pragma unroll
                    for (int s = 0; s < 4; ++s) { const bf16x8 kf = *(const bf16x8*)((const bf16_t*)bA + l31 * 72 + 16 * s + 8 * hi); sA = __builtin_amdgcn_mfma_f32_32x32x16_bf16(kf, qf[s], sA, 0, 0, 0); } }
                if (vB) {
#pragma unroll
                    for (int s = 0; s < 4; ++s) { const bf16x8 kf = *(const bf16x8*)((const bf16_t*)bB + l31 * 72 + 16 * s + 8 * hi); sB = __builtin_amdgcn_mfma_f32_32x32x16_bf16(kf, qf[s], sB, 0, 0, 0); } }
                if (jA == 4 * qb + wq) {
                    asm volatile("" ::: "memory");
#pragma unroll
                    for (int r = 0; r < 16; ++r) { const int kpos = 32 * jA + 8 * (r >> 2) + 4 * hi + (r & 3); if (kpos > qp) sA[r] = -INFINITY; } }
                if (jB == 4 * qb + wq) {
                    asm volatile("" ::: "memory");
#pragma unroll
                    for (int r = 0; r < 16; ++r) { const int kpos = 32 * jB + 8 * (r >> 2) + 4 * hi + (r & 3); if (kpos > qp) sB[r] = -INFINITY; } }
                float tmax = -INFINITY;
#pragma unroll
                for (int r = 0; r < 16; ++r) tmax = fmaxf(tmax, fmaxf(sA[r], sB[r]));
                tmax = fmaxf(tmax, __shfl_xor(tmax, 32));
                const float mnew = fmaxf(m, tmax), muse = mnew == -INFINITY ? 0.f : mnew;
                const float alpha = __builtin_amdgcn_exp2f(m - muse);
                m = mnew; lsum *= alpha;
#pragma unroll
                for (int r = 0; r < 16; ++r) { o0[r] *= alpha; o1[r] *= alpha; }
                float ps = 0.f;
#pragma unroll
                for (int r = 0; r < 16; ++r) { const float pa = __builtin_amdgcn_exp2f(sA[r] - muse), pb = __builtin_amdgcn_exp2f(sB[r] - muse); sA[r] = pa; sB[r] = pb; ps += pa + pb; }
                lsum += ps;
#define ATT_PV(SV, BB) do { const bf16_t* Vt = (const bf16_t*)((BB) + 4608); _Pragma("unroll") for (int s = 0; s < 2; ++s) { \
                    u32x4 pw; pw.x = cvt_pk_bf16(SV[8 * s + 0], SV[8 * s + 1]); pw.y = cvt_pk_bf16(SV[8 * s + 2], SV[8 * s + 3]); pw.z = cvt_pk_bf16(SV[8 * s + 4], SV[8 * s + 5]); pw.w = cvt_pk_bf16(SV[8 * s + 6], SV[8 * s + 7]); \
                    const bf16x8 pf = __builtin_bit_cast(bf16x8, pw); \
                    { const bf16_t* vp = Vt + l31 * 40 + 16 * s + 4 * hi; const u32x2 lo = *(const u32x2*)vp, hi2 = *(const u32x2*)(vp + 8); u32x4 vv; vv.x = lo.x; vv.y = lo.y; vv.z = hi2.x; vv.w = hi2.y; \
                      o0 = __builtin_amdgcn_mfma_f32_32x32x16_bf16(__builtin_bit_cast(bf16x8, vv), pf, o0, 0, 0, 0); } \
                    { const bf16_t* vp = Vt + (32 + l31) * 40 + 16 * s + 4 * hi; const u32x2 lo = *(const u32x2*)vp, hi2 = *(const u32x2*)(vp + 8); u32x4 vv; vv.x = lo.x; vv.y = lo.y; vv.z = hi2.x; vv.w = hi2.y; \
                      o1 = __builtin_amdgcn_mfma_f32_32x32x16_bf16(__builtin_bit_cast(bf16x8, vv), pf, o1, 0, 0, 0); } } } while (0)
                if (vA) ATT_PV(sA, bA);
                if (vB) ATT_PV(sB, bB);
#undef ATT_PV
            }
        }
        if (sc + 1 < nsc) LDS_BARRIER();
    }
#undef ATT_LOAD4
#undef ATT_STORE4
    lsum += __shfl_xor(lsum, 32);
    float* cb = comb + (size_t)(wq * 64 + lane) * 34;
    if (g == 1) { cb[0] = m; cb[1] = lsum;
#pragma unroll
        for (int r = 0; r < 16; ++r) { cb[2 + r] = o0[r]; cb[18 + r] = o1[r]; } }
    LDS_BARRIER();
    if (g == 0 && qp >= NPAD && !dry) {
        const float m1 = cb[0], l1 = cb[1];
        const float mf = fmaxf(m, m1), a0 = __builtin_amdgcn_exp2f(m - mf), a1 = __builtin_amdgcn_exp2f(m1 - mf);
        const float inv = 1.0f / (lsum * a0 + l1 * a1);
        bf16_t* op = P + (rowbase + qp) * PP + C_FQ + 64 * hh + 4 * hi;
#pragma unroll
        for (int g4 = 0; g4 < 4; ++g4) {
            u32x2 w0, w1; float t0[4], t1[4];
#pragma unroll
            for (int i = 0; i < 4; ++i) { t0[i] = (o0[4 * g4 + i] * a0 + cb[2 + 4 * g4 + i] * a1) * inv; t1[i] = (o1[4 * g4 + i] * a0 + cb[18 + 4 * g4 + i] * a1) * inv; }
            w0.x = cvt_pk_bf16(t0[0], t0[1]); w0.y = cvt_pk_bf16(t0[2], t0[3]); w1.x = cvt_pk_bf16(t1[0], t1[1]); w1.y = cvt_pk_bf16(t1[2], t1[3]);
            *(u32x2*)(op + 8 * g4) = w0; *(u32x2*)(op + 32 + 8 * g4) = w1;
        }
    }
    LDS_BARRIER();
}
__device__ __forceinline__ void attn_phase(bf16_t* P, const float* CUM, const unsigned* KMAX, unsigned char* lds, const bool dry) {
    const int c = blockIdx.x, G = gridDim.x;
    for (int rd = 0;; ++rd) {
        const int idx = (rd & 1) ? (rd + 1) * G - 1 - c : rd * G + c;
        if (rd * G >= 16 * NCH) break;
        if (idx >= 16 * NCH) continue;
        const int qb = NCH - 1 - idx / 16, bh = idx & 15;
        attn_unit(bh >> 3, bh & 7, qb, P, CUM, KMAX, lds, dry);
    }
}

constexpr int L_CB = 0, L_QT = 32768, L_KT = 51200, L_VT = 69632, L_ST = 104448, L_GAL = 122880;
static_assert(L_GAL + 8192 <= LDS_MAIN, "GLA LDS map");
__device__ __forceinline__ void gla_cb(int b, int hh, int c, const Args& ar, int layer, unsigned char* lds) {
    const int tid = otid(), k = tid & 63, seg = tid >> 6;
    float* CB = (float*)(lds + L_CB); float* SEG = (float*)(lds + L_QT); float* GAL = (float*)(lds + L_GAL);
    const float* GA = (const float*)(ar.ws + WS_GA);
    const size_t r0 = (size_t)b * LP + (size_t)BLK * c;
    *(f32x4*)(GAL + 4 * tid) = *(const f32x4*)(GA + r0 * 16 + 4 * tid);
    float wcol[16];
#pragma unroll
    for (int r = 0; r < 16; ++r) wcol[r] = ar.w_alpha_up[(size_t)layer * 16 * 256 + r * 256 + 64 * hh + k];
    const float bias = ar.b_alpha[layer * 256 + 64 * hh + k];
    __syncthreads();
    float vals[16]; float run = 0.f;
#pragma unroll
    for (int i = 0; i < 16; ++i) { const int t = 16 * seg + i; float x = bias;
#pragma unroll
        for (int r4 = 0; r4 < 4; ++r4) { const f32x4 gv = *(const f32x4*)(GAL + t * 16 + 4 * r4); x += gv[0] * wcol[4 * r4] + gv[1] * wcol[4 * r4 + 1] + gv[2] * wcol[4 * r4 + 2] + gv[3] * wcol[4 * r4 + 3]; }
        const float la = (BLK * c + t >= NPAD) ? logsigmoidf(x) * (1.0f / 16.0f) : 0.f;
        run += la; vals[i] = run; }
    SEG[seg * 64 + k] = run;
    __syncthreads();
    float off = 0.f;
#pragma unroll
    for (int s = 0; s < 8; ++s) off += (s < seg) ? SEG[s * 64 + k] : 0.f;
#pragma unroll
    for (int i = 0; i < 16; ++i) CB[(16 * seg + i) * 64 + k] = vals[i] + off;
    __syncthreads();
}
__device__ __forceinline__ void gla_load_v(u32x4 (&vr)[4], const bf16_t* P, size_t r0, int hh, int tid) {
#pragma unroll
    for (int i = 0; i < 4; ++i) { const int idx = tid + 512 * i, s = idx & 127, c16 = idx >> 7; vr[i] = *(const u32x4*)(P + (r0 + s) * PP + C_GV + 128 * hh + 8 * c16); }
}
__device__ __forceinline__ void gla_store_vt(const u32x4 (&vr)[4], unsigned char* lds, int tid) {
    bf16_t* VT = (bf16_t*)(lds + L_VT);
#pragma unroll
    for (int i = 0; i < 4; ++i) { const int idx = tid + 512 * i, s = idx & 127, c16 = idx >> 7; const u32x4 v = vr[i];
        bf16_t* vt = VT + (8 * c16) * 136 + s;
        vt[0] = (bf16_t)v.x; vt[136] = (bf16_t)(v.x >> 16); vt[272] = (bf16_t)v.y; vt[408] = (bf16_t)(v.y >> 16); vt[544] = (bf16_t)v.z; vt[680] = (bf16_t)(v.z >> 16); vt[816] = (bf16_t)v.w; vt[952] = (bf16_t)(v.w >> 16); }
}
__device__ __forceinline__ void gla_g1_unit(int b, int hh, int c, const Args& ar, int layer, unsigned char* lds) {
    const int tid = otid(), k = tid & 63, seg = tid >> 6, lane = tid & 63, w = tid >> 6, l15 = lane & 15, quad = lane >> 4;
    const bf16_t* P = (const bf16_t*)(ar.ws + WS_R2); float* STG = (float*)(ar.ws + WS_R1); float* DEC = (float*)(ar.ws + WS_DEC);
    const int unit = (b * 4 + hh) * NCH + c; const size_t r0 = (size_t)b * LP + (size_t)BLK * c;
    unsigned short kraw[16]; u32x4 vraw[4];
#pragma unroll
    for (int i = 0; i < 16; ++i) kraw[i] = P[(r0 + 16 * seg + i) * PP + C_GK + 64 * hh + k];
    gla_load_v(vraw, P, r0, hh, tid);
    gla_cb(b, hh, c, ar, layer, lds);
    const float* CB = (const float*)(lds + L_CB); bf16_t* KHT = (bf16_t*)(lds + L_KT); const bf16_t* VT = (const bf16_t*)(lds + L_VT);
    { const float cl = CB[127 * 64 + k]; unsigned pk[8];
#pragma unroll
      for (int i = 0; i < 16; i += 2) { const int t = 16 * seg + i;
          const float k0 = bf2f(kraw[i]) * __expf(cl - CB[t * 64 + k]);
          const float k1 = bf2f(kraw[i + 1]) * __expf(cl - CB[(t + 1) * 64 + k]);
          pk[i >> 1] = cvt_pk_bf16(k0, k1); }
      u32x4 w0, w1; w0.x = pk[0]; w0.y = pk[1]; w0.z = pk[2]; w0.w = pk[3]; w1.x = pk[4]; w1.y = pk[5]; w1.z = pk[6]; w1.w = pk[7];
      *(u32x4*)(KHT + k * 136 + 16 * seg) = w0; *(u32x4*)(KHT + k * 136 + 16 * seg + 8) = w1;
      if (seg == 0) DEC[unit * 64 + k] = __expf(cl); }
    gla_store_vt(vraw, lds, tid);
    __syncthreads();
#pragma unroll
    for (int kt = 0; kt < 4; ++kt) { f32x4 acc = {0.f, 0.f, 0.f, 0.f};
#pragma unroll
        for (int ks = 0; ks < 4; ++ks) { const bf16x8 af = *(const bf16x8*)(KHT + (16 * kt + l15) * 136 + 32 * ks + 8 * quad); const bf16x8 bfr = *(const bf16x8*)(VT + (16 * w + l15) * 136 + 32 * ks + 8 * quad);
            acc = __builtin_amdgcn_mfma_f32_16x16x32_bf16(af, bfr, acc, 0, 0, 0); }
        *(f32x4*)(STG + ((size_t)unit * 128 + 16 * w + l15) * 64 + 16 * kt + 4 * quad) = acc; }
    __syncthreads();
}
__device__ __forceinline__ void gla_g2_phase(const Args& ar) {
    float* STG = (float*)(ar.ws + WS_R1); const float* DEC = (const float*)(ar.ws + WS_DEC);
    const int gid = blockIdx.x * NTHREADS + otid();
    if (gid >= 8 * 8192) return;
    const int bh = gid >> 13, e = gid & 8191, k = e & 63;
    float carry = 0.f;
    float u[13], d[13], un[13], dn[13];
#pragma unroll
    for (int i = 0; i < 13; ++i) { const int unit = bh * NCH + i; u[i] = STG[(size_t)unit * 8192 + e]; d[i] = DEC[unit * 64 + k]; }
#pragma unroll 1
    for (int c0 = 0; c0 < NCH; c0 += 13) {
        if (c0 + 13 < NCH) {
#pragma unroll
            for (int i = 0; i < 13; ++i) { const int unit = bh * NCH + c0 + 13 + i; un[i] = STG[(size_t)unit * 8192 + e]; dn[i] = DEC[unit * 64 + k]; } }
#pragma unroll
        for (int i = 0; i < 13; ++i) { const int unit = bh * NCH + c0 + i; STG[(size_t)unit * 8192 + e] = carry; carry = d[i] * carry + u[i]; }
#pragma unroll
        for (int i = 0; i < 13; ++i) { u[i] = un[i]; d[i] = dn[i]; }
    }
}
__device__ __forceinline__ void gla_g3_unit(int b, int hh, int c, const Args& ar, int layer, unsigned char* lds, const bool dry) {
    const int tid = otid(), k = tid & 63, seg = tid >> 6, lane = tid & 63, w = tid >> 6, l15 = lane & 15, quad = lane >> 4;
    bf16_t* P = (bf16_t*)(ar.ws + WS_R2); const float* STG = (const float*)(ar.ws + WS_R1);
    const int unit = (b * 4 + hh) * NCH + c; const size_t r0 = (size_t)b * LP + (size_t)BLK * c;
    unsigned short qraw[16], kraw[16]; float sraw[16]; u32x4 vraw[4];
#pragma unroll
    for (int i = 0; i < 16; ++i) { const bf16_t* pp = P + (r0 + 16 * seg + i) * PP + 64 * hh + k; qraw[i] = pp[C_GQ]; kraw[i] = pp[C_GK]; }
#pragma unroll
    for (int i = 0; i < 16; ++i) sraw[i] = c == 0 ? 0.f : STG[((size_t)unit * 128 + seg + 8 * i) * 64 + k];
    gla_load_v(vraw, P, r0, hh, tid);
    u32x2 grraw[8];
    { const bf16_t* gp = P + (r0 + 16 * w + l15) * PP + C_GR + 128 * hh + 4 * quad;
#pragma unroll
      for (int vt = 0; vt < 8; ++vt) grraw[vt] = *(const u32x2*)(gp + 16 * vt); }
    gla_cb(b, hh, c, ar, layer, lds);
    const float* CB = (const float*)(lds + L_CB); bf16_t* QT = (bf16_t*)(lds + L_QT); bf16_t* KT = (bf16_t*)(lds + L_KT); const bf16_t* VT = (const bf16_t*)(lds + L_VT); bf16_t* ST = (bf16_t*)(lds + L_ST);
    const float ref = CB[63 * 64 + k];
    __syncthreads();
#pragma unroll
    for (int i = 0; i < 16; ++i) { const int t = 16 * seg + i; const float cbv = CB[t * 64 + k];
        const float qv = bf2f(qraw[i]) * __expf(cbv - ref);
        const float kv = bf2f(kraw[i]) * __expf(ref - cbv);
        QT[t * 72 + k] = (bf16_t)(cvt_pk_bf16(qv, 0.f)); KT[t * 72 + k] = (bf16_t)(cvt_pk_bf16(kv, 0.f)); }
    { const float er = __expf(ref);
#pragma unroll
      for (int i = 0; i < 16; ++i) { const int v = seg + 8 * i; ST[v * 72 + k] = (bf16_t)cvt_pk_bf16(sraw[i] * er, 0.f); } }
    gla_store_vt(vraw, lds, tid);
    __syncthreads();
    f32x4 acc[8];
#pragma unroll
    for (int vt = 0; vt < 8; ++vt) acc[vt] = (f32x4){0.f, 0.f, 0.f, 0.f};
    bf16x8 bq[2];
#pragma unroll
    for (int ks = 0; ks < 2; ++ks) bq[ks] = *(const bf16x8*)(QT + (16 * w + l15) * 72 + 32 * ks + 8 * quad);
#pragma unroll
    for (int ks = 0; ks < 2; ++ks)
#pragma unroll
        for (int vt = 0; vt < 8; ++vt) { const bf16x8 af = *(const bf16x8*)(ST + (16 * vt + l15) * 72 + 32 * ks + 8 * quad); acc[vt] = __builtin_amdgcn_mfma_f32_16x16x32_bf16(af, bq[ks], acc[vt], 0, 0, 0); }
    const int npairs = (w >> 1) + 1, tq = 16 * w + l15;
    for (int pr = 0; pr < npairs; ++pr) {
        f32x4 x0 = {0.f, 0.f, 0.f, 0.f}, x1 = x0;
#pragma unroll
        for (int ks = 0; ks < 2; ++ks) { const bf16x8 a0 = *(const bf16x8*)(KT + (32 * pr + l15) * 72 + 32 * ks + 8 * quad); const bf16x8 a1 = *(const bf16x8*)(KT + (32 * pr + 16 + l15) * 72 + 32 * ks + 8 * quad);
            x0 = __builtin_amdgcn_mfma_f32_16x16x32_bf16(a0, bq[ks], x0, 0, 0, 0); x1 = __builtin_amdgcn_mfma_f32_16x16x32_bf16(a1, bq[ks], x1, 0, 0, 0); }
#pragma unroll
        for (int j = 0; j < 4; ++j) { const int s0 = 32 * pr + 4 * quad + j; if (s0 > tq) x0[j] = 0.f; if (s0 + 16 > tq) x1[j] = 0.f; }
        u32x4 pw; pw.x = cvt_pk_bf16(x0[0], x0[1]); pw.y = cvt_pk_bf16(x0[2], x0[3]); pw.z = cvt_pk_bf16(x1[0], x1[1]); pw.w = cvt_pk_bf16(x1[2], x1[3]);
        const bf16x8 pf = __builtin_bit_cast(bf16x8, pw);
#pragma unroll
        for (int vt = 0; vt < 8; ++vt) { const bf16_t* vp = VT + (16 * vt + l15) * 136 + 32 * pr + 4 * quad; const u32x2 lo = *(const u32x2*)vp, hi2 = *(const u32x2*)(vp + 16);
            u32x4 vv; vv.x = lo.x; vv.y = lo.y; vv.z = hi2.x; vv.w = hi2.y;
            acc[vt] = __builtin_amdgcn_mfma_f32_16x16x32_bf16(__builtin_bit_cast(bf16x8, vv), pf, acc[vt], 0, 0, 0); }
    }
    float ss = 0.f;
#pragma unroll
    for (int vt = 0; vt < 8; ++vt) ss += acc[vt][0] * acc[vt][0] + acc[vt][1] * acc[vt][1] + acc[vt][2] * acc[vt][2] + acc[vt][3] * acc[vt][3];
    ss += __shfl_xor(ss, 16); ss += __shfl_xor(ss, 32);
    const float rs = rsqrtf(ss * (1.0f / 128.0f) + RMS_EPS);
    const float* gg = ar.g_gla_out + layer * 512 + 128 * hh;
    bf16_t* op = P + (r0 + tq) * PP + C_GR + 128 * hh + 4 * quad;
#pragma unroll
    for (int vt = 0; vt < 8; ++vt) { const u32x2 gr = grraw[vt]; const f32x4 g4 = *(const f32x4*)(gg + 16 * vt + 4 * quad);
        const float r0v = __uint_as_float(gr.x << 16), r1v = __uint_as_float(gr.x & 0xffff0000u), r2v = __uint_as_float(gr.y << 16), r3v = __uint_as_float(gr.y & 0xffff0000u);
        u32x2 wv; wv.x = cvt_pk_bf16(acc[vt][0] * rs * g4[0] * r0v, acc[vt][1] * rs * g4[1] * r1v); wv.y = cvt_pk_bf16(acc[vt][2] * rs * g4[2] * r2v, acc[vt][3] * rs * g4[3] * r3v);
        if (!dry) *(u32x2*)(op + 16 * vt) = wv; }
    __syncthreads();
}


constexpr int MAIN_ROWS = 64 * 256;
template <int EPI, int NS>
__device__ __forceinline__ void thin_gemm(const bf16_t* A, int lda, const bf16_t* Bt, int K, bf16_t* O, int ldc, bf16_t* P, unsigned char* lds) {
    const int tid = otid(), lane = tid & 63, w = tid >> 6, l31 = lane & 31, hi = lane >> 5;
    float* red = (float*)lds;
    for (int piece = blockIdx.x; piece < 256; piece += gridDim.x) {
        const int m0 = MAIN_ROWS + 32 * (piece >> 5), n0 = 32 * (piece & 31);
        const int kw = K >> 3, kb = w * kw;
        const bf16_t* ap = A + (size_t)(m0 + l31) * lda + kb + 8 * hi;
        const bf16_t* bp = Bt + (size_t)(n0 + l31) * K + kb + 8 * hi;
        f32x16 acc;
#pragma unroll
        for (int r = 0; r < 16; ++r) acc[r] = 0.f;
        bf16x8 wfr[NS], afr[NS];
#pragma unroll
        for (int s = 0; s < NS; ++s) { wfr[s] = *(const bf16x8*)(bp + 16 * s); afr[s] = *(const bf16x8*)(ap + 16 * s); }
#pragma unroll
        for (int s = 0; s < NS; ++s) acc = __builtin_amdgcn_mfma_f32_32x32x16_bf16(wfr[s], afr[s], acc, 0, 0, 0);
#pragma unroll
        for (int r = 0; r < 16; ++r) red[(w * 16 + r) * 64 + lane] = acc[r];
        __syncthreads();
        float v0 = 0.f, v1 = 0.f;
#pragma unroll
        for (int ww = 0; ww < 8; ++ww) { v0 += red[(ww * 16 + 2 * w) * 64 + lane]; v1 += red[(ww * 16 + 2 * w + 1) * 64 + lane]; }
        const int m = m0 + l31, n = n0 + ((2 * w) & 3) + 8 * ((2 * w) >> 2) + 4 * hi;
        if (EPI == 0) { *(unsigned*)(O + (size_t)m * ldc + n) = cvt_pk_bf16(v0, v1); }
        else { bf16_t* rowp = P + (size_t)m * PP + n; const unsigned gq = *(const unsigned*)(rowp + (EPI == 1 ? C_GTA : C_GTB));
            const float g0 = __uint_as_float(gq << 16), g1 = __uint_as_float(gq & 0xffff0000u);
            float t0 = 0.f, t1 = 0.f; if (EPI == 2) { const unsigned tq = *(const unsigned*)(rowp + C_YM); t0 = __uint_as_float(tq << 16); t1 = __uint_as_float(tq & 0xffff0000u); }
            *(unsigned*)(rowp + C_YM) = cvt_pk_bf16(t0 + v0 * g0, t1 + v1 * g1); }
        __syncthreads();
    }
}

#define XB_TMO      128
#define XB_XCNT(j)  (256  + 64 * (j))
#define XB_XSUB(j)  (1280 + 64 * (j))
#define XB_XGEN(j)  (2304 + 64 * (j))
#define XB_TOP      3328
#define XB_TOPGEN   3392
#define XCD_BAR_WORDS 3456
#define XB_SPIN_CAP (1u << 18)
#define LAS __attribute__((address_space(3)))

__device__ __forceinline__ unsigned xb_ld(unsigned* p)              { return __hip_atomic_load(p, __ATOMIC_RELAXED, __HIP_MEMORY_SCOPE_AGENT); }
__device__ __forceinline__ unsigned xb_add(unsigned* p, unsigned v) { return __hip_atomic_fetch_add(p, v, __ATOMIC_RELAXED, __HIP_MEMORY_SCOPE_AGENT); }
__device__ __forceinline__ unsigned xb_xcc_id() { return (unsigned)__builtin_amdgcn_s_getreg((3 << 11) | 20) & 0xFu; }
#define XB_SPIN(cond, bar) do { unsigned _sp = 0; while (cond) { __builtin_amdgcn_s_sleep(1); \
    if ((++_sp & 255u) == 0u) { if (xb_ld(&(bar)[XB_TMO])) break; if (_sp > XB_SPIN_CAP) { atomicAdd(&(bar)[XB_TMO], 1u); break; } } } } while (0)

struct XcdBarrier {
    unsigned* bar; unsigned x;
    volatile LAS unsigned* st;
};

__device__ unsigned g_bar[XCD_BAR_WORDS + 64];
__device__ __forceinline__ XcdBarrier xcd_barrier_post(unsigned* bar, volatile LAS unsigned* st) {
    XcdBarrier b; b.bar = bar; b.x = xb_xcc_id(); b.st = st;
    if (threadIdx.x == 0) (void)xb_add(&bar[XB_XCNT(b.x)], 1u);
    return b;
}
__device__ __forceinline__ void xcd_barrier_complete(unsigned* bar, unsigned x, unsigned& nloc, unsigned& nx) {
    const unsigned G = gridDim.x * gridDim.y * gridDim.z;
    unsigned sum, cnt, mine, sp = 0u;
    for (;;) {
        sum = 0u; cnt = 0u; mine = 0u;
#pragma unroll
        for (unsigned j = 0; j < 16; ++j) { const unsigned c = xb_ld(&bar[XB_XCNT(j)]); sum += c; cnt += (c > 0u) ? 1u : 0u; mine = (j == x) ? c : mine; }
        if (sum == G) break;
        __builtin_amdgcn_s_sleep(1);
        if ((++sp & 255u) == 0u) { if (xb_ld(&bar[XB_TMO])) break; if (sp > XB_SPIN_CAP) { atomicAdd(&bar[XB_TMO], 1u); break; } }
    }
    nloc = mine > 0u ? mine : 1u; nx = cnt > 0u ? cnt : 1u;
}

__device__ __forceinline__ void xcd_barrier(const XcdBarrier& b) {
    asm volatile("s_waitcnt vmcnt(0)" ::: "memory");
    __syncthreads();
    if (threadIdx.x == 0) {
        unsigned* bar = b.bar;
        __builtin_amdgcn_s_waitcnt(0);
        unsigned nloc = b.st[0], nx = b.st[1];
        if (nloc == 0u) { xcd_barrier_complete(bar, b.x, nloc, nx); b.st[0] = nloc; b.st[1] = nx; }
        const unsigned old = xb_add(&bar[XB_XSUB(b.x)], 1u);
        const unsigned gen = old / nloc;
        if (old + 1u == (gen + 1u) * nloc) {
            __builtin_amdgcn_fence(__ATOMIC_RELEASE, "agent");
            asm volatile("s_waitcnt vmcnt(0)" ::: "memory");
            const unsigned og = xb_add(&bar[XB_TOP], 1u);
            const unsigned tg = og / nx;
            if (og + 1u == (tg + 1u) * nx) {
                xb_add(&bar[XB_TOPGEN], 1u);
#pragma unroll
                for (unsigned j = 0; j < 16; ++j) xb_add(&bar[XB_XGEN(j)], 1u);
            } else XB_SPIN(xb_ld(&bar[XB_TOPGEN]) == tg, bar);
            __builtin_amdgcn_fence(__ATOMIC_ACQUIRE, "agent");
            asm volatile("s_waitcnt vmcnt(0)" ::: "memory");
        } else {
            XB_SPIN(xb_ld(&bar[XB_XGEN(b.x)]) == gen, bar);
            __builtin_amdgcn_fence(__ATOMIC_ACQUIRE, "agent");
            asm volatile("s_waitcnt vmcnt(0)" ::: "memory");
        }
    }
    __syncthreads();
}


__global__ void __launch_bounds__(NTHREADS, 2) fwd_megakernel(Args ar) {
    extern __shared__ __attribute__((aligned(16))) unsigned char lds[];
    cg::grid_group grid = cg::this_grid();
    if (gridDim.x == 0x7fffffffu) grid.sync();
    { const int t0_ = otid(); if (t0_ < 4) ((PG8_LAS unsigned*)(lds + LDS_MAIN))[t0_] = 0u; }
    __syncthreads();
    const XcdBarrier xbar = xcd_barrier_post(g_bar, (volatile LAS unsigned*)(PG8_LAS unsigned*)(lds + LDS_MAIN));
#ifdef PROBE_SYNC
#define GSYNC() do { xcd_barrier(xbar); xcd_barrier(xbar); } while (0)
#else
#define GSYNC() xcd_barrier(xbar)
#endif
    PG8_LAS unsigned char* lds3 = (PG8_LAS unsigned char*)lds;
    unsigned char* ws = ar.ws;
    bf16_t* R1 = (bf16_t*)(ws + WS_R1); bf16_t* R2 = (bf16_t*)(ws + WS_R2);
    float* LF = (float*)(ws + WS_LF); float* GA = (float*)(ws + WS_GA); float* CUM = (float*)(ws + WS_CUM); unsigned* KMAXW = (unsigned*)(ws + WS_KMAX);
    const int G = gridDim.x, cblk = blockIdx.x;

#pragma unroll 1
    for (int it = 0; it <= DEPTH; ++it) {
      const int layer = it - 1;
      if (layer >= 0) {
#pragma unroll 1
        for (int ffn = 0; ffn < 2; ++ffn) {
            if (ffn == 1) {
                { const int t0_ = otid(); if (cblk == 0 && t0_ < 16) KMAXW[t0_] = 0u; }
                { pg8::Gemm g{R1, (const bf16_t*)(ws + WS_WIN), MR, NINP, DM, DM}; pg8::StaticOrder S; S.init(MR, NINP, G, cblk);
                  pg8::EpiInProj E{R2, LF, GA, ar.b_f + layer * 8};
                  pg8::gemm_phase<pg8::EpiInProj, pg8::StaticOrder, true, true>(lds3, g, S, E); }
                GSYNC();
                cumsum_phase(LF, CUM, lds);
                kmax_phase(R2, KMAXW, lds);
                for (int u = cblk; u < 8 * 64; u += G) gla_g1_unit(u >> 8, (u >> 6) & 3, u & 63, ar, layer, lds);
#ifdef PROBE_G1
                for (int u = cblk; u < 8 * 64; u += G) gla_g1_unit(u >> 8, (u >> 6) & 3, u & 63, ar, layer, lds);
#endif
                GSYNC();
                gla_g2_phase(ar);
                if (G >= 136) { if (cblk >= 128 && cblk < 136) gla_g3_unit((cblk - 128) >> 2, (cblk - 128) & 3, 0, ar, layer, lds, false); }
                else if (cblk == 0) { for (int u = 0; u < 8; ++u) gla_g3_unit(u >> 2, u & 3, 0, ar, layer, lds, false); }
#ifdef PROBE_ATTN
                attn_phase(R2, CUM, KMAXW, lds, true);
#endif
                attn_phase(R2, CUM, KMAXW, lds, false);
                GSYNC();
#ifdef PROBE_G3
                for (int u = cblk; u < 8 * 64; u += G) gla_g3_unit(u >> 8, (u >> 6) & 3, 1 + (u & 63), ar, layer, lds, true);
#endif
                for (int u = cblk; u < 8 * 64; u += G) gla_g3_unit(u >> 8, (u >> 6) & 3, 1 + (u & 63), ar, layer, lds, false);
                { pg8::Gemm g{R2 + C_FQ, (const bf16_t*)(ws + WS_WFO), MAIN_ROWS, DM, 512, PP}; pg8::StaticOrder S; S.init(MAIN_ROWS, DM, G, cblk);
                  pg8::EpiMerge1 E{R2};
                  pg8::gemm_phase<pg8::EpiMerge1, pg8::StaticOrder, true, true>(lds3, g, S, E); }
                thin_gemm<1, 4>(R2 + C_FQ, PP, (const bf16_t*)(ws + WS_WFO), 512, nullptr, 0, R2, lds);
                GSYNC();
                { pg8::Gemm g{R2 + C_GR, (const bf16_t*)(ws + WS_WGO), MAIN_ROWS, DM, 512, PP}; pg8::StaticOrder S; S.init(MAIN_ROWS, DM, G, cblk);
                  pg8::EpiMerge2 E{R2};
                  pg8::gemm_phase<pg8::EpiMerge2, pg8::StaticOrder, true, true>(lds3, g, S, E); }
                thin_gemm<2, 4>(R2 + C_GR, PP, (const bf16_t*)(ws + WS_WGO), 512, nullptr, 0, R2, lds);
                GSYNC();
                { pg8::Gemm g{R2 + C_YM, (const bf16_t*)(ws + WS_WOUT), MAIN_ROWS, DM, DM, PP}; pg8::StaticOrder S; S.init(MAIN_ROWS, DM, G, cblk);
                  pg8::EpiPlain E{R1, DM};
                  pg8::gemm_phase<pg8::EpiPlain, pg8::StaticOrder, true, true>(lds3, g, S, E); }
                thin_gemm<0, 8>(R2 + C_YM, PP, (const bf16_t*)(ws + WS_WOUT), DM, R1, DM, nullptr, lds);
                GSYNC();
#ifdef PROBE_NORM
                norm_phase<1>(ar, R1, R1, 1.0f, ar.g_postm + layer * DM, ar.g_pre2 + layer * DM, true);
#endif
                norm_phase<1>(ar, R1, R1, 1.0f, ar.g_postm + layer * DM, ar.g_pre2 + layer * DM);
                GSYNC();
            }
            { pg8::Gemm g{R1, (const bf16_t*)(ws + (ffn ? WS_WGU2 : WS_WGU1)), MR, NGU, DM, DM}; pg8::StaticOrder S; S.init(MR, NGU, G, cblk);
              pg8::EpiSwiglu E{R2, DFF};
              pg8::gemm_phase<pg8::EpiSwiglu, pg8::StaticOrder, true, true>(lds3, g, S, E);
#ifdef PROBE_GU
              __syncthreads(); pg8::gemm_phase<pg8::EpiSwiglu, pg8::StaticOrder, true, true>(lds3, g, S, E);
#endif
            }
            GSYNC();
            { pg8::Gemm g{R2, (const bf16_t*)(ws + (ffn ? WS_WD2 : WS_WD1)), MAIN_ROWS, DM, DFF, DFF}; pg8::StaticOrder S; S.init(MAIN_ROWS, DM, G, cblk);
              pg8::EpiPlain E{R1, DM};
              pg8::gemm_phase<pg8::EpiPlain, pg8::StaticOrder, true, true>(lds3, g, S, E);
#ifdef PROBE_DOWN
              __syncthreads(); pg8::gemm_phase<pg8::EpiPlain, pg8::StaticOrder, true, true>(lds3, g, S, E);
#endif
            }
            thin_gemm<0, 22>(R2, DFF, (const bf16_t*)(ws + (ffn ? WS_WD2 : WS_WD1)), DFF, R1, DM, nullptr, lds);
#ifdef PROBE_THIN
            thin_gemm<0, 22>(R2, DFF, (const bf16_t*)(ws + (ffn ? WS_WD2 : WS_WD1)), DFF, R1, DM, nullptr, lds);
#endif
            GSYNC();
#ifdef PROBE_NORM
            norm_phase<1>(ar, R1, R1, 0.5f, ar.g_post1 + layer * DM, ar.g_prem + layer * DM, true);
#endif
            if (ffn == 0) norm_phase<1>(ar, R1, R1, 0.5f, ar.g_post1 + layer * DM, ar.g_prem + layer * DM);
            else norm_phase<1>(ar, R1, R1, 0.5f, ar.g_post2 + layer * DM, layer + 1 < DEPTH ? ar.g_pre1 + (layer + 1) * DM : nullptr);
            if (ffn == 0) GSYNC();
        }
      }
      if (it < DEPTH) convert_phase(ar, it, lds);
      if (it == 0) norm_phase<0>(ar, nullptr, R1, 0.f, nullptr, ar.g_pre1);
      if (it < DEPTH) GSYNC();
    }
    __syncthreads();
    { const int t = otid(); PG8_LAS unsigned* flag = (PG8_LAS unsigned*)(lds + LDS_MAIN) + 2;
      if (t == 0) { const unsigned old = __hip_atomic_fetch_add(&g_bar[XCD_BAR_WORDS], 1u, __ATOMIC_RELAXED, __HIP_MEMORY_SCOPE_AGENT); flag[0] = (old + 1u == gridDim.x) ? 1u : 0u; }
      __syncthreads();
      if (flag[0]) { for (int i = t; i < XCD_BAR_WORDS + 64; i += NTHREADS) __hip_atomic_store(&g_bar[i], 0u, __ATOMIC_RELAXED, __HIP_MEMORY_SCOPE_AGENT); } }
}

extern "C" void kernel_launch(void* const* d_in, const int* in_sizes, int n_in, void* d_out, int out_size, void* d_ws, size_t ws_size, hipStream_t stream) {
    static int grid = 0;
    if (grid == 0) {
        if (n_in != 20 || out_size != NB * SEQ * DM || ws_size < WS_END) { fprintf(stderr, "kernel_launch: unexpected shapes (n_in %d, out %d, ws %zu < %zu); nothing launched\n", n_in, out_size, ws_size, (size_t)WS_END); grid = -1; return; }
        int dev = 0, cus = 0, per_cu = 0;
        hipGetDevice(&dev); hipDeviceGetAttribute(&cus, hipDeviceAttributeMultiprocessorCount, dev);
        if (hipFuncSetAttribute((const void*)fwd_megakernel, hipFuncAttributeMaxDynamicSharedMemorySize, LDS_BYTES) != hipSuccess) { fprintf(stderr, "kernel_launch: hipFuncSetAttribute failed\n"); grid = -1; return; }
        if (hipOccupancyMaxActiveBlocksPerMultiprocessor(&per_cu, (const void*)fwd_megakernel, NTHREADS, LDS_BYTES) != hipSuccess || per_cu < 1) per_cu = 1;
        (void)hipGetLastError();
        grid = cus > 0 ? cus : 256;
    }
    if (grid < 0) return;
    Args a{};
    const float* const* in = (const float* const*)d_in;
    a.x = in[0]; a.meta = in[1]; a.w_in = in[2]; a.w_alpha_up = in[3]; a.b_alpha = in[4]; a.b_f = in[5]; a.g_gla_out = in[6]; a.w_fox_o = in[7]; a.w_gla_o = in[8]; a.w_out = in[9];
    a.w_gu1 = in[10]; a.w_d1 = in[11]; a.w_gu2 = in[12]; a.w_d2 = in[13]; a.g_pre1 = in[14]; a.g_post1 = in[15]; a.g_prem = in[16]; a.g_postm = in[17]; a.g_pre2 = in[18]; a.g_post2 = in[19];
    a.out = (float*)d_out; a.ws = (unsigned char*)d_ws;
    void* args[] = {&a};
    hipError_t e = hipLaunchCooperativeKernel((const void*)fwd_megakernel, dim3(grid), dim3(NTHREADS), args, LDS_BYTES, stream);
    if (e != hipSuccess) fprintf(stderr, "cooperative launch failed: %s (grid %d)\n", hipGetErrorString(e), grid);
}
```
